# Optimizing an MI355X kernel written in HIP

```python
import math
import jax, jax.numpy as jnp
from jax import lax
import numpy as np


D_MODEL = 1024
BATCH = 4
SEQ = 4096
DEPTH = 2

HEAD_DIM = 128
FOX_HEADS = 4
GDN_HEADS = 4
MOBA_HEADS = D_MODEL // HEAD_DIM
FOX_WIDTH = FOX_HEADS * HEAD_DIM
GDN_WIDTH = GDN_HEADS * HEAD_DIM
MOBA_WIDTH = MOBA_HEADS * HEAD_DIM
Q_BLOCK = 128
GDN_CHUNK = 64
CONV_WIDTH = 4
MOBA_BLOCK = 256
MOBA_TOPK = 3
MOBA_Q_CHUNK = 16
D_FF_DENSE = 2816
N_EXPERTS = 8
TOP_K_EXPERTS = 2
D_FF_EXPERT = 3584
ROPE_THETA = 10000.0
EPS = 1e-6
N_EVEN = (DEPTH + 1) // 2
N_ODD = DEPTH // 2
IN_WIDTHS = (FOX_WIDTH, FOX_WIDTH, FOX_WIDTH, FOX_HEADS, GDN_WIDTH, GDN_WIDTH, GDN_WIDTH, GDN_HEADS, GDN_HEADS, GDN_WIDTH)
IN_COLS = sum(IN_WIDTHS)

kernel_name = 'hybrid_fox_gdn_moba_moe'

F32 = jnp.float32


def rms_norm(x, gain):
    xf = x.astype(F32)
    y = xf * lax.rsqrt(jnp.mean(xf * xf, axis=-1, keepdims=True) + EPS)
    return (y * gain.astype(F32)).astype(x.dtype)


def l2_normalize(x):
    xf = x.astype(F32)
    return xf * lax.rsqrt(jnp.sum(xf * xf, axis=-1, keepdims=True) + EPS)


def to_heads(t, n):
    B, S, _ = t.shape
    return t.reshape(B, S, n, HEAD_DIM).transpose(0, 2, 1, 3)


def from_heads(t):
    B, H, S, D = t.shape
    return t.transpose(0, 2, 1, 3).reshape(B, S, H * D)


def rope(x, pos):
    half = HEAD_DIM // 2
    inv = jnp.power(ROPE_THETA, -jnp.arange(half, dtype=F32) / half)
    ang = pos.astype(F32)[:, None] * inv[None, :]
    cos, sin = jnp.cos(ang), jnp.sin(ang)
    xf = x.astype(F32)
    x1, x2 = xf[..., :half], xf[..., half:]
    return jnp.concatenate([x1 * cos - x2 * sin, x2 * cos + x1 * sin], axis=-1).astype(x.dtype)


def forgetting_attention(q, k, v, log_f):
    B, H, S, D = q.shape
    F = jnp.cumsum(log_f, axis=-1)
    scale = D ** -0.5
    kpos = jnp.arange(S)

    def block(i):
        start = i * Q_BLOCK
        qb = lax.dynamic_slice_in_dim(q, start, Q_BLOCK, axis=2)
        Fq = lax.dynamic_slice_in_dim(F, start, Q_BLOCK, axis=2)
        qpos = start + jnp.arange(Q_BLOCK)
        s = jnp.einsum('bhqd,bhkd->bhqk', qb, k, preferred_element_type=F32) * scale
        s = s + Fq[..., :, None] - F[..., None, :]
        s = jnp.where(kpos[None, :] <= qpos[:, None], s, -jnp.inf)
        p = jax.nn.softmax(s, axis=-1)
        return jnp.einsum('bhqk,bhkd->bhqd', p.astype(v.dtype), v)

    out = lax.map(block, jnp.arange(S // Q_BLOCK))
    return jnp.moveaxis(out, 0, 2).reshape(B, H, S, D)


def causal_depthwise_conv(x, w):
    K, C = w.shape
    return lax.conv_general_dilated(x, w[:, None, :], window_strides=(1,), padding=[(K - 1, 0)],
                                    dimension_numbers=('NWC', 'WIO', 'NWC'), feature_group_count=C)


def gated_delta_rule(q, k, v, g, beta):
    B, H, S, Dk = q.shape
    Dv = v.shape[-1]
    C = GDN_CHUNK
    N = S // C
    q = q * Dk ** -0.5
    q, k, v = (t.reshape(B, H, N, C, t.shape[-1]) for t in (q, k, v))
    g, beta = (t.reshape(B, H, N, C) for t in (g, beta))
    gc = jnp.cumsum(g, axis=-1)
    idx = jnp.arange(C)
    strict = idx[:, None] > idx[None, :]
    incl = idx[:, None] >= idx[None, :]
    diff = gc[..., :, None] - gc[..., None, :]
    decay = jnp.where(incl, jnp.exp(jnp.where(incl, diff, 0.0)), 0.0)
    kb = k * beta[..., None]
    M = jnp.where(strict, jnp.einsum('bhncd,bhnsd->bhncs', kb, k) * decay, 0.0)
    A = jnp.eye(C, dtype=F32) + M
    rhs = jnp.concatenate([v * beta[..., None], kb * jnp.exp(gc)[..., None]], axis=-1)
    sol = lax.linalg.triangular_solve(A, rhs, left_side=True, lower=True, unit_diagonal=True)
    u, w = sol[..., :Dv], sol[..., Dv:]
    attn = jnp.einsum('bhncd,bhnsd->bhncs', q, k) * decay
    qg = q * jnp.exp(gc)[..., None]
    kg = k * jnp.exp(gc[..., -1:] - gc)[..., None]
    glast = jnp.exp(gc[..., -1])

    def step(state, xs):
        u_c, w_c, attn_c, qg_c, kg_c, gl_c = xs
        v_new = u_c - jnp.einsum('bhcd,bhde->bhce', w_c, state)
        o = jnp.einsum('bhcd,bhde->bhce', qg_c, state) + jnp.einsum('bhcs,bhse->bhce', attn_c, v_new)
        state = state * gl_c[..., None, None] + jnp.einsum('bhcd,bhce->bhde', kg_c, v_new)
        return state, o

    xs = tuple(jnp.moveaxis(t, 2, 0) for t in (u, w, attn, qg, kg, glast))
    _, o = lax.scan(step, jnp.zeros((B, H, Dk, Dv), F32), xs)
    return jnp.moveaxis(o, 0, 2).reshape(B, H, S, Dv)


def gdn_branch(gq, gk, gv, ga, gb, gg, conv_w, a_log, dt_bias, o_norm):
    B, S, _ = gq.shape
    qkv = jnp.concatenate([gq, gk, gv], axis=-1).astype(F32)
    qkv = jax.nn.silu(causal_depthwise_conv(qkv, conv_w.astype(F32)))
    q, k, v = jnp.split(qkv, 3, axis=-1)
    q = l2_normalize(to_heads(q, GDN_HEADS))
    k = l2_normalize(to_heads(k, GDN_HEADS))
    v = to_heads(v, GDN_HEADS)
    beta = jax.nn.sigmoid(gb.astype(F32)).transpose(0, 2, 1)
    g = (-jnp.exp(a_log.astype(F32)) * jax.nn.softplus(ga.astype(F32) + dt_bias.astype(F32))).transpose(0, 2, 1)
    o = gated_delta_rule(q, k, v, g, beta)
    o = rms_norm(o.transpose(0, 2, 1, 3), o_norm) * jax.nn.silu(gg.astype(F32).reshape(B, S, GDN_HEADS, HEAD_DIM))
    return o.reshape(B, S, GDN_WIDTH).astype(gq.dtype)


def even_mixer(h, w_in, fox_f_bias, fox_q_norm, fox_k_norm, gdn_conv, gdn_a_log, gdn_dt_bias, gdn_o_norm, w_out):
    z = h @ w_in
    offsets = np.cumsum(IN_WIDTHS)[:-1].tolist()
    fq, fk, fv, ff, gq, gk, gv, ga, gb, gg = jnp.split(z, offsets, axis=-1)
    q = rms_norm(to_heads(fq, FOX_HEADS), fox_q_norm)
    k = rms_norm(to_heads(fk, FOX_HEADS), fox_k_norm)
    v = to_heads(fv, FOX_HEADS)
    log_f = jax.nn.log_sigmoid(ff.astype(F32) + fox_f_bias.astype(F32)).transpose(0, 2, 1)
    fox_out = from_heads(forgetting_attention(q, k, v, log_f))
    gdn_out = gdn_branch(gq, gk, gv, ga, gb, gg, gdn_conv, gdn_a_log, gdn_dt_bias, gdn_o_norm)
    return jnp.concatenate([fox_out, gdn_out.astype(fox_out.dtype)], axis=-1) @ w_out


def moba_attention(q, k, v):
    B, H, S, D = q.shape
    nblk = -(-S // MOBA_BLOCK)
    pad = nblk * MOBA_BLOCK - S
    if pad:
        k = jnp.pad(k, ((0, 0), (0, 0), (0, pad), (0, 0)))
        v = jnp.pad(v, ((0, 0), (0, 0), (0, pad), (0, 0)))
    topk = min(MOBA_TOPK, nblk)
    scale = D ** -0.5
    kb = k.reshape(B, H, nblk, MOBA_BLOCK, D)
    vb = v.reshape(B, H, nblk, MOBA_BLOCK, D)
    kmean = jnp.mean(kb.astype(F32), axis=3)
    k_flat = kb.reshape(B * H * nblk, MOBA_BLOCK, D)
    v_flat = vb.reshape(B * H * nblk, MOBA_BLOCK, D)
    bh_off = (jnp.arange(B * H) * nblk).reshape(B, H, 1, 1)
    blk_ids = jnp.arange(nblk)
    inner = jnp.arange(MOBA_Q_CHUNK)
    kin = jnp.arange(MOBA_BLOCK)
    n_sel = topk * MOBA_BLOCK

    def chunk(ci):
        start = ci * MOBA_Q_CHUNK
        qc = lax.dynamic_slice_in_dim(q, start, MOBA_Q_CHUNK, axis=2)
        cur = start // MOBA_BLOCK
        gate = jnp.einsum('bhqd,bhnd->bhqn', qc.astype(F32), kmean)
        gate = jnp.where(blk_ids < cur, gate, -jnp.inf)
        _, sel = lax.top_k(gate, topk)
        valid = sel < cur
        ks = k_flat[bh_off + sel]
        vs = v_flat[bh_off + sel]
        s_sel = jnp.einsum('bhqd,bhqjsd->bhqjs', qc, ks, preferred_element_type=F32) * scale
        s_sel = jnp.where(valid[..., None], s_sel, -jnp.inf).reshape(B, H, MOBA_Q_CHUNK, n_sel)
        k_own = kb[:, :, cur]
        v_own = vb[:, :, cur]
        qpos_in = start - cur * MOBA_BLOCK + inner
        s_own = jnp.einsum('bhqd,bhsd->bhqs', qc, k_own, preferred_element_type=F32) * scale
        s_own = jnp.where(kin[None, :] <= qpos_in[:, None], s_own, -jnp.inf)
        p = jax.nn.softmax(jnp.concatenate([s_sel, s_own], axis=-1), axis=-1).astype(v.dtype)
        p_sel = p[..., :n_sel].reshape(B, H, MOBA_Q_CHUNK, topk, MOBA_BLOCK)
        return (jnp.einsum('bhqjs,bhqjsd->bhqd', p_sel, vs)
                + jnp.einsum('bhqs,bhsd->bhqd', p[..., n_sel:], v_own))

    out = lax.map(chunk, jnp.arange(S // MOBA_Q_CHUNK))
    return jnp.moveaxis(out, 0, 2).reshape(B, H, S, D)


def odd_mixer(h, w_qkv, q_norm, k_norm, w_out, pos):
    fq, fk, fv = jnp.split(h @ w_qkv, 3, axis=-1)
    q = rope(rms_norm(to_heads(fq, MOBA_HEADS), q_norm), pos)
    k = rope(rms_norm(to_heads(fk, MOBA_HEADS), k_norm), pos)
    v = to_heads(fv, MOBA_HEADS)
    return from_heads(moba_attention(q, k, v)) @ w_out


def swiglu(h, w_gate_up, w_down):
    gt, up = jnp.split(h @ w_gate_up, 2, axis=-1)
    return (jax.nn.silu(gt) * up) @ w_down


def moe_swiglu(h, w_router, w_gate_up, w_down):
    B, S, D = h.shape
    t = h.reshape(B * S, D)
    logits = (t @ w_router).astype(F32)
    top_v, top_i = lax.top_k(logits, TOP_K_EXPERTS)
    gates = jax.nn.softmax(top_v, axis=-1)
    combine = jnp.sum(jax.nn.one_hot(top_i, N_EXPERTS, dtype=F32) * gates[..., None], axis=1)
    out = jnp.zeros_like(t)
    for e in range(N_EXPERTS):
        out = out + combine[:, e:e + 1].astype(t.dtype) * swiglu(t, w_gate_up[e], w_down[e])
    return out.reshape(B, S, D)


def setup_inputs(seed: int = 0) -> dict:
    key = jax.random.key(seed)
    ks = jax.random.split(key, 32)

    def nrm(k, shape, scale):
        return jax.random.normal(k, shape, F32) * scale

    NE, NO = N_EVEN, N_ODD
    dinv = D_MODEL ** -0.5
    dt = jnp.exp(jax.random.uniform(ks[8], (NE, GDN_HEADS), F32, math.log(1e-3), math.log(1e-1)))
    return {
        'x': nrm(ks[0], (BATCH, SEQ, D_MODEL), 1.0),
        'e_norm1': 1.0 + nrm(ks[1], (NE, D_MODEL), 0.02),
        'e_w_in': nrm(ks[2], (NE, D_MODEL, IN_COLS), dinv),
        'e_fox_f_bias': 2.0 + nrm(ks[3], (NE, FOX_HEADS), 0.5),
        'e_fox_q_norm': 1.0 + nrm(ks[4], (NE, HEAD_DIM), 0.02),
        'e_fox_k_norm': 1.0 + nrm(ks[5], (NE, HEAD_DIM), 0.02),
        'e_gdn_conv': nrm(ks[6], (NE, CONV_WIDTH, 3 * GDN_WIDTH), CONV_WIDTH ** -0.5),
        'e_gdn_a_log': jnp.log(jax.random.uniform(ks[7], (NE, GDN_HEADS), F32, 1.0, 16.0)),
        'e_gdn_dt_bias': dt + jnp.log(-jnp.expm1(-dt)),
        'e_gdn_o_norm': 1.0 + nrm(ks[9], (NE, HEAD_DIM), 0.02),
        'e_w_out': nrm(ks[10], (NE, FOX_WIDTH + GDN_WIDTH, D_MODEL), (FOX_WIDTH + GDN_WIDTH) ** -0.5),
        'e_norm2': 1.0 + nrm(ks[11], (NE, D_MODEL), 0.02),
        'e_ffn_w_gate_up': nrm(ks[12], (NE, D_MODEL, 2 * D_FF_DENSE), dinv),
        'e_ffn_w_down': nrm(ks[13], (NE, D_FF_DENSE, D_MODEL), D_FF_DENSE ** -0.5),
        'o_norm1': 1.0 + nrm(ks[14], (NO, D_MODEL), 0.02),
        'o_w_qkv': nrm(ks[15], (NO, D_MODEL, 3 * MOBA_WIDTH), dinv),
        'o_q_norm': 1.0 + nrm(ks[16], (NO, HEAD_DIM), 0.02),
        'o_k_norm': 1.0 + nrm(ks[17], (NO, HEAD_DIM), 0.02),
        'o_w_out': nrm(ks[18], (NO, MOBA_WIDTH, D_MODEL), MOBA_WIDTH ** -0.5),
        'o_norm2': 1.0 + nrm(ks[19], (NO, D_MODEL), 0.02),
        'o_router': nrm(ks[20], (NO, D_MODEL, N_EXPERTS), dinv),
        'o_exp_w_gate_up': nrm(ks[21], (NO, N_EXPERTS, D_MODEL, 2 * D_FF_EXPERT), dinv),
        'o_exp_w_down': nrm(ks[22], (NO, N_EXPERTS, D_FF_EXPERT, D_MODEL), D_FF_EXPERT ** -0.5),
    }


def reference(x, e_norm1, e_w_in, e_fox_f_bias, e_fox_q_norm, e_fox_k_norm, e_gdn_conv, e_gdn_a_log,
              e_gdn_dt_bias, e_gdn_o_norm, e_w_out, e_norm2, e_ffn_w_gate_up, e_ffn_w_down,
              o_norm1, o_w_qkv, o_q_norm, o_k_norm, o_w_out, o_norm2, o_router, o_exp_w_gate_up, o_exp_w_down):
    pos = jnp.arange(x.shape[1])
    h = x
    for layer in range(DEPTH):
        i = layer // 2
        if layer % 2 == 0:
            h = h + even_mixer(rms_norm(h, e_norm1[i]), e_w_in[i], e_fox_f_bias[i], e_fox_q_norm[i], e_fox_k_norm[i],
                               e_gdn_conv[i], e_gdn_a_log[i], e_gdn_dt_bias[i], e_gdn_o_norm[i], e_w_out[i])
            h = h + swiglu(rms_norm(h, e_norm2[i]), e_ffn_w_gate_up[i], e_ffn_w_down[i])
        else:
            h = h + odd_mixer(rms_norm(h, o_norm1[i]), o_w_qkv[i], o_q_norm[i], o_k_norm[i], o_w_out[i], pos)
            h = h + moe_swiglu(rms_norm(h, o_norm2[i]), o_router[i], o_exp_w_gate_up[i], o_exp_w_down[i])
    return h
```

```cpp
#include <hip/hip_runtime.h>
#include <stdint.h>
#include <math.h>
#include <string.h>
namespace at {
#define LAS __attribute__((address_space(3)))
typedef unsigned short bf16_t;
typedef short bf16x8 __attribute__((ext_vector_type(8)));
typedef short s16x4 __attribute__((ext_vector_type(4)));
typedef float f32x16 __attribute__((ext_vector_type(16)));
typedef float f32x4 __attribute__((ext_vector_type(4)));
typedef unsigned u32x4 __attribute__((ext_vector_type(4)));
constexpr float SCALE = 0.08838834764831845f;
constexpr float THR = 8.f;
constexpr int NW = 8, QBLK = 32, KVBLK = 64, D = 128, SEQL = 4096;
constexpr int SHM_V = KVBLK * D * 2, SHM_K = KVBLK * D * 2;
constexpr int OFF_WS = 2 * SHM_V + 2 * SHM_K;
constexpr int OFF_BIAS = OFF_WS + NW * 64 * 4;
constexpr int ATTN_LDS = OFF_BIAS + SEQL * 4;

#define KSWZ(row, colB) ((row) * 256 + ((colB) ^ (((row) & 7) << 4)))
#define SBAR() __builtin_amdgcn_sched_barrier(0)
__device__ __forceinline__ int v_st(int k, int c) { const int kk = (k & ~0xC) | ((k & 4) << 1) | ((k & 8) >> 1); return ((kk >> 3) * 4 + (c >> 5)) * 512 + ((kk & 7) * 32 + (c & 31)) * 2; }
__device__ __forceinline__ int v_rd_base(int lane) { return ((lane & 3) << 3) | (((lane >> 2) & 3) << 6) | (((lane >> 4) & 1) << 5) | (((lane >> 5) & 1) << 8); }
constexpr int v_rd_off(int d0, int ks, int half) { return d0 * 512 + ks * 4096 + half * 2048; }
__device__ __forceinline__ int crow(int r, int hi) { return (r & 3) + 8 * (r >> 2) + 4 * hi; }
__device__ __forceinline__ unsigned cvtpk(float lo, float hi) { unsigned r; asm volatile("v_cvt_pk_bf16_f32 %0, %1, %2" : "=v"(r) : "v"(lo), "v"(hi)); return r; }
__device__ __forceinline__ bf16x8 load8(const bf16_t* p) { return *reinterpret_cast<const bf16x8*>(p); }

__device__ __forceinline__ void mask_tile(f32x16& p0, f32x16& p1, int dq) {
    const float NEG = -__builtin_inff();
#pragma unroll
    for (int r = 0; r < 16; ++r) {
        const int c = (r & 3) + 8 * (r >> 2);
        if (dq - c < 0) p0[r] = NEG;
        if (dq - c - 32 < 0) p1[r] = NEG;
    }
}
__device__ __forceinline__ void partialSM(f32x16& p0, f32x16& p1, float& m_reg, float& mn, float& alpha) {
    float pmax = p0[0]; for (int r = 1; r < 16; ++r) pmax = fmaxf(pmax, p0[r]); for (int r = 0; r < 16; ++r) pmax = fmaxf(pmax, p1[r]);
    { auto rr = __builtin_amdgcn_permlane32_swap(__float_as_uint(pmax), __float_as_uint(pmax), false, false);
      pmax = fmaxf(__uint_as_float(rr[0]), __uint_as_float(rr[1])); }
    constexpr float C2 = 1.4426950408889634f * SCALE;
    if (__builtin_expect(__all((pmax - m_reg) * SCALE <= THR), 1)) { mn = m_reg; alpha = 1.f; }
    else { mn = fmaxf(m_reg, pmax); alpha = __builtin_amdgcn_exp2f((m_reg - mn) * C2); m_reg = mn; }
    const float mnL = -mn * C2;
    for (int r = 0; r < 16; ++r) p0[r] = fmaf(p0[r], C2, mnL); for (int r = 0; r < 16; ++r) p1[r] = fmaf(p1[r], C2, mnL);
    for (int r = 0; r < 16; ++r) p0[r] = __builtin_amdgcn_exp2f(p0[r]);
}
__device__ __forceinline__ void finishSM(f32x16& p0, f32x16& p1, float alpha, float& l_reg, bf16x8& pa0, bf16x8& pa1, bf16x8& pa2, bf16x8& pa3) {
    for (int r = 0; r < 16; ++r) p1[r] = __builtin_amdgcn_exp2f(p1[r]);
    float ps = 0; for (int r = 0; r < 16; ++r) ps += p0[r]; for (int r = 0; r < 16; ++r) ps += p1[r];
    { auto rr = __builtin_amdgcn_permlane32_swap(__float_as_uint(ps), __float_as_uint(ps), false, false);
      ps = __uint_as_float(rr[0]) + __uint_as_float(rr[1]); }
    l_reg = l_reg * alpha + ps;
#define PK4(P, B_, OUT) do { unsigned a0 = cvtpk(P[B_+0], P[B_+1]), a1 = cvtpk(P[B_+2], P[B_+3]);                          \
        unsigned b0 = cvtpk(P[B_+4], P[B_+5]), b1 = cvtpk(P[B_+6], P[B_+7]);                                             \
        auto r0 = __builtin_amdgcn_permlane32_swap(a0, b0, false, false); auto r1 = __builtin_amdgcn_permlane32_swap(a1, b1, false, false); \
        u32x4 w = {r0[0], r1[0], r0[1], r1[1]}; OUT = *reinterpret_cast<bf16x8*>(&w); } while (0)
    PK4(p0, 0, pa0); PK4(p0, 8, pa1); PK4(p1, 0, pa2); PK4(p1, 8, pa3);
#undef PK4
}
template <int KB, int MODE>
__device__ __forceinline__ void qkt(f32x16& p0, f32x16& p1, LAS const char* K_lds, int r32, int hi, const bf16x8* qr, bool act, LAS const float* bias_kb) {
    if (!act) { const float NEG = -__builtin_inff();
#pragma unroll
        for (int r = 0; r < 16; ++r) { p0[r] = NEG; p1[r] = NEG; } return; }
    if (MODE == 0) {
#pragma unroll
        for (int g = 0; g < 4; ++g) { const f32x4 b0 = *(LAS const f32x4*)(bias_kb + 8 * g + 4 * hi), b1 = *(LAS const f32x4*)(bias_kb + 32 + 8 * g + 4 * hi);
#pragma unroll
            for (int j = 0; j < 4; ++j) { p0[4 * g + j] = b0[j]; p1[4 * g + j] = b1[j]; } }
    } else { p0 = f32x16{}; p1 = f32x16{}; }
    LAS const char* kb[4];
#pragma unroll
    for (int dd = 0; dd < 4; ++dd) kb[dd] = K_lds + KB * SHM_K + KSWZ(r32, (dd * 16 + hi * 8) * 2);
#pragma unroll
    for (int d0 = 0; d0 < 8; ++d0) { LAS const char* a = kb[d0 & 3] + (d0 >> 2) * 128;
        bf16x8 b0 = *(LAS const bf16x8*)(a);
        bf16x8 b1 = *(LAS const bf16x8*)(a + 32 * 256);
        p0 = __builtin_amdgcn_mfma_f32_32x32x16_bf16(b0, qr[d0], p0, 0, 0, 0);
        p1 = __builtin_amdgcn_mfma_f32_32x32x16_bf16(b1, qr[d0], p1, 0, 0, 0); }
}
template <int VB>
__device__ __forceinline__ void pv_tile(f32x16* o, int vb0, bf16x8 pa0, bf16x8 pa1, bf16x8 pa2, bf16x8 pa3, bool act) {
    if (!act) return;
#define TRRD(dst, off) asm volatile("ds_read_b64_tr_b16 %0, %1 offset:%2" : "=&v"(dst) : "v"(vb0), "i"(off) : "memory")
#define PV_D0(d0) do { s16x4 l0, l1, l2, l3, h0, h1, h2, h3; constexpr int b_ = VB * SHM_V + v_rd_off(d0, 0, 0); \
        TRRD(l0, b_); TRRD(h0, b_ + 2048); TRRD(l1, b_ + 4096); TRRD(h1, b_ + 6144); TRRD(l2, b_ + 8192); TRRD(h2, b_ + 10240); TRRD(l3, b_ + 12288); TRRD(h3, b_ + 14336); \
        asm volatile("s_waitcnt lgkmcnt(0)" ::: "memory"); SBAR();   \
        o[d0] = __builtin_amdgcn_mfma_f32_32x32x16_bf16(pa0, (bf16x8){l0[0], l0[1], l0[2], l0[3], h0[0], h0[1], h0[2], h0[3]}, o[d0], 0, 0, 0);   \
        o[d0] = __builtin_amdgcn_mfma_f32_32x32x16_bf16(pa1, (bf16x8){l1[0], l1[1], l1[2], l1[3], h1[0], h1[1], h1[2], h1[3]}, o[d0], 0, 0, 0);   \
        o[d0] = __builtin_amdgcn_mfma_f32_32x32x16_bf16(pa2, (bf16x8){l2[0], l2[1], l2[2], l2[3], h2[0], h2[1], h2[2], h2[3]}, o[d0], 0, 0, 0);   \
        o[d0] = __builtin_amdgcn_mfma_f32_32x32x16_bf16(pa3, (bf16x8){l3[0], l3[1], l3[2], l3[3], h3[0], h3[1], h3[2], h3[3]}, o[d0], 0, 0, 0); } while (0)
    PV_D0(0); PV_D0(1); PV_D0(2); PV_D0(3);
#undef PV_D0
#undef TRRD
}

template <int MODE, int PITCH, int OP>
__device__ __forceinline__ void attn_unit(const bf16_t* Q, const bf16_t* K, const bf16_t* V, bf16_t* O, const float* aux, int pa, int pb, LAS char* lds) {
    const int tid = threadIdx.x; const int wid = __builtin_amdgcn_readfirstlane(tid >> 6), lane = tid & 63, r32 = lane & 31, hi = lane >> 5;
    int jlo = 0, NT = 2 * (pb + 1);
    const int qlo = 128 * (wid < 4 ? pa : pb) + 32 * (wid & 3), qm = qlo + r32 - 4 * hi;
    LAS char* V_lds = lds; LAS char* K_lds = lds + 2 * SHM_V;
    LAS float* wsf = (LAS float*)(lds + OFF_WS) + wid * 64; LAS float* li_l = wsf; LAS float* al_l = wsf + 32;
    LAS float* auxl = (LAS float*)(lds + OFF_BIAS);
    float m_reg = -1e30f, l_reg = 0; f32x16 o[4] = {};
    const int sr = tid >> 4, sc = (tid & 15) * 8, vst0 = v_st(sr, sc), vst1 = v_st(32 + sr, sc), kws = KSWZ(sr, sc * 2);
    const int vb0 = (int)(unsigned)(uintptr_t)V_lds + v_rd_base(lane);
    bf16x8 qr[8]; bf16x8 st_v0, st_v1, st_k0, st_k1;
#define ROW(p, k0, rr) ((const bf16_t*)((const char*)(p) + (unsigned)((((k0) + (rr)) * PITCH + sc) * 2)))
#define VMW() asm volatile("s_waitcnt vmcnt(0)" ::: "memory")
#define SLOAD_H(k0) do { st_v0 = load8(ROW(V, k0, sr)); st_v1 = load8(ROW(V, k0, 32 + sr)); st_k0 = load8(ROW(K, k0, sr)); st_k1 = load8(ROW(K, k0, 32 + sr)); } while (0)
#define SWRITE_HK(bf) do { *(LAS bf16x8*)(K_lds + (bf) * SHM_K + kws) = st_k0; *(LAS bf16x8*)(K_lds + (bf) * SHM_K + kws + 32 * 256) = st_k1; } while (0)
#define SWRITE_HV(bf) do { *(LAS bf16x8*)(V_lds + (bf) * SHM_V + vst0) = st_v0; *(LAS bf16x8*)(V_lds + (bf) * SHM_V + vst1) = st_v1; } while (0)
#define SWRITE_H(bf) do { SWRITE_HV(bf); SWRITE_HK(bf); } while (0)
#pragma unroll
    for (int d0 = 0; d0 < 8; ++d0) qr[d0] = load8((const bf16_t*)((const char*)Q + (unsigned)(((qlo + r32) * PITCH + d0 * 16 + hi * 8) * 2)));
    if (MODE == 0) { for (int i = tid; i < (pb + 1) * 128 / 4; i += 512) ((LAS f32x4*)auxl)[i] = ((const f32x4*)aux)[i]; }
    else { for (int i = tid; i < 16 * 128 / 4; i += 512) ((LAS f32x4*)auxl)[i] = ((const f32x4*)aux)[i]; }
    if (MODE == 0) {
        __syncthreads();
        const float thr = aux[4096], f0 = auxl[128 * pa];
        const int j = lane < NT ? lane : NT - 1;
        const unsigned long long bal = __ballot(lane < NT && (f0 - auxl[64 * j + 63]) > thr);
        jlo = __builtin_amdgcn_readfirstlane(__popcll(bal)) & ~1; if (jlo > NT - 2) jlo = NT - 2;
        NT -= jlo;
    }
    SLOAD_H(jlo * KVBLK); VMW(); SWRITE_HK(0);
    __syncthreads();
    unsigned selm = 0u, wsel = 0u; const int curw = qlo >> 8;
    if (MODE == 1) {
        float g[16];
#pragma unroll
        for (int j = 0; j < 16; ++j) g[j] = 0.f;
#pragma unroll
        for (int d0 = 0; d0 < 8; ++d0) {
            float qf[8];
#pragma unroll
            for (int e = 0; e < 8; ++e) qf[e] = __uint_as_float(((unsigned)(unsigned short)qr[d0][e]) << 16);
#pragma unroll
            for (int j = 0; j < 15; ++j) { if (j < curw) { const f32x4 k0 = *(LAS const f32x4*)(auxl + j * 128 + d0 * 16 + hi * 8), k1 = *(LAS const f32x4*)(auxl + j * 128 + d0 * 16 + hi * 8 + 4);
                g[j] += (qf[0] * k0[0] + qf[1] * k0[1]) + (qf[2] * k0[2] + qf[3] * k0[3]) + (qf[4] * k1[0] + qf[5] * k1[1]) + (qf[6] * k1[2] + qf[7] * k1[3]); } }
        }
#pragma unroll
        for (int j = 0; j < 15; ++j) { auto rr = __builtin_amdgcn_permlane32_swap(__float_as_uint(g[j]), __float_as_uint(g[j]), false, false); g[j] = __uint_as_float(rr[0]) + __uint_as_float(rr[1]); }
#pragma unroll
        for (int k = 0; k < 3; ++k) { int best = -1; float bv = -__builtin_inff();
#pragma unroll
            for (int j = 0; j < 15; ++j) if (j < curw && !((selm >> j) & 1u) && g[j] > bv) { bv = g[j]; best = j; }
            if (best >= 0) selm |= 1u << best; }
#pragma unroll
        for (int j = 0; j < 15; ++j) if (__any((selm >> j) & 1u)) wsel |= 1u << j;
        wsel = __builtin_amdgcn_readfirstlane(wsel);
    }
#define KBASE(t) ((jlo + (t)) * KVBLK)
#define ACT(t) (KBASE(t) <= qlo + QBLK - 1 && (MODE == 0 || (KBASE(t) >> 8) == curw || ((wsel >> (KBASE(t) >> 8)) & 1u)))
#define MASKT(P0_, P1_, t) do { const int kb_ = KBASE(t); if (ACT(t)) { if (kb_ + KVBLK - 1 > qlo) mask_tile(P0_, P1_, qm - kb_); \
        if (MODE == 1 && (kb_ >> 8) < curw && !((selm >> (kb_ >> 8)) & 1u)) { const float NEG_ = -__builtin_inff(); _Pragma("unroll") for (int r_ = 0; r_ < 16; ++r_) { P0_[r_] = NEG_; P1_[r_] = NEG_; } } } } while (0)
#define RESC(a) do { if (__any((a) < 1.f)) { if (hi == 0) al_l[r32] = (a); asm volatile("s_waitcnt lgkmcnt(0)" ::: "memory");              \
                     for (int d_ = 0; d_ < 4; ++d_) for (int r = 0; r < 16; ++r) o[d_][r] *= al_l[crow(r, hi)]; } } while (0)
    f32x16 pA0, pA1, pB0, pB1; float mnA, mnB, alA, alB; bf16x8 pa0, pa1, pa2, pa3;
    SWRITE_HV(0); SBAR();
    SLOAD_H(KBASE(1));
    SBAR(); qkt<0, MODE>(pA0, pA1, K_lds, r32, hi, qr, ACT(0), auxl + KBASE(0));
    MASKT(pA0, pA1, 0); partialSM(pA0, pA1, m_reg, mnA, alA);
    VMW(); SWRITE_H(1);
    __syncthreads();
#define HALF_STEP(PX0, PX1, mnX, alX, PY0, PY1, alY, t, KB, VB, SB) do {                                                      \
        SBAR(); qkt<KB, MODE>(PX0, PX1, K_lds, r32, hi, qr, ACT(t), auxl + KBASE(t));                                         \
        finishSM(PY0, PY1, alY, l_reg, pa0, pa1, pa2, pa3); SBAR();                                                           \
        if ((t) + 1 < NT) { SLOAD_H(KBASE((t) + 1)); SBAR(); }                                                                \
        pv_tile<VB>(o, vb0, pa0, pa1, pa2, pa3, ACT((t) - 1)); MASKT(PX0, PX1, (t)); partialSM(PX0, PX1, m_reg, mnX, alX);    \
        __syncthreads();                                                                                                      \
        if ((t) + 1 < NT) { VMW(); SWRITE_H(SB); }                                                                            \
        RESC(alX); __syncthreads(); } while (0)
    for (int t = 1; t + 1 < NT; t += 2) {
        HALF_STEP(pB0, pB1, mnB, alB, pA0, pA1, alA, t, 1, 0, 0);
        HALF_STEP(pA0, pA1, mnA, alA, pB0, pB1, alB, t + 1, 0, 1, 1);
    }
    SBAR(); qkt<1, MODE>(pB0, pB1, K_lds, r32, hi, qr, ACT(NT - 1), auxl + KBASE(NT - 1)); SBAR();
    finishSM(pA0, pA1, alA, l_reg, pa0, pa1, pa2, pa3); SBAR();
    pv_tile<0>(o, vb0, pa0, pa1, pa2, pa3, ACT(NT - 2));
    MASKT(pB0, pB1, NT - 1); partialSM(pB0, pB1, m_reg, mnB, alB); __syncthreads(); RESC(alB);
    finishSM(pB0, pB1, alB, l_reg, pa0, pa1, pa2, pa3); SBAR(); pv_tile<1>(o, vb0, pa0, pa1, pa2, pa3, ACT(NT - 1));
    SBAR();
    if (hi == 0) li_l[r32] = l_reg; asm volatile("s_waitcnt lgkmcnt(0)" ::: "memory");
    float rli[16];
#pragma unroll
    for (int r = 0; r < 16; ++r) rli[r] = __builtin_amdgcn_rcpf(li_l[crow(r, hi)]);
    bf16_t* Ow = O + (size_t)qlo * OP;
#pragma unroll
    for (int r = 0; r < 16; ++r) { const int orow = crow(r, hi);
#pragma unroll
        for (int d0 = 0; d0 < 4; ++d0) { const float v = o[d0][r] * rli[r];
            const float vn = __shfl_xor(v, 1);
            if ((r32 & 1) == 0) *(unsigned*)(Ow + (size_t)orow * OP + d0 * 32 + r32) = cvtpk(v, vn); } }
    __syncthreads();
#undef RESC
#undef KBASE
#undef ACT
#undef MASKT
#undef HALF_STEP
#undef ROW
#undef VMW
#undef SLOAD_H
#undef SWRITE_HK
#undef SWRITE_HV
#undef SWRITE_H
}
#undef KSWZ
#undef SBAR
#undef LAS
}
namespace gd {
#ifndef GD_DBG_BEGIN
#define GD_DBG_BEGIN(k)
#define GD_DBG_END(k)
#endif
#define LAS __attribute__((address_space(3)))
typedef unsigned short bf16_t;
typedef short bf16x8 __attribute__((ext_vector_type(8)));
typedef float f32x16 __attribute__((ext_vector_type(16)));
typedef float f32x4 __attribute__((ext_vector_type(4)));
typedef float f32x2 __attribute__((ext_vector_type(2)));
typedef unsigned u32x4 __attribute__((ext_vector_type(4)));
typedef unsigned u32x2 __attribute__((ext_vector_type(2)));
constexpr int G_QS = 0, G_K = 16384, G_KGT = 32768, G_RHS = 49152, G_M = 114688, G_ATT = 131072, G_SC = 139264, G_RS = 139264 + 1024;
__device__ __forceinline__ unsigned cvtpk(float lo, float hi) { unsigned r; asm volatile("v_cvt_pk_bf16_f32 %0, %1, %2" : "=v"(r) : "v"(lo), "v"(hi)); return r; }
__device__ __forceinline__ float bflo(unsigned u) { return __uint_as_float(u << 16); }
__device__ __forceinline__ float bfhi(unsigned u) { return __uint_as_float(u & 0xffff0000u); }
__device__ __forceinline__ float silu_f(float x) { return x * __builtin_amdgcn_rcpf(1.f + __builtin_amdgcn_exp2f(-1.4426950408889634f * x)); }
__device__ __forceinline__ int off256(int row, int ch) { return row * 256 + ((ch ^ (row & 15)) << 4); }
__device__ __forceinline__ int off128(int row, int ch) { return row * 128 + ((ch ^ (row & 7)) << 4); }
__device__ __forceinline__ int crow(int r, int hi) { return (r & 3) + 8 * (r >> 2) + 4 * hi; }
#define GD_BAR() do { asm volatile("s_waitcnt lgkmcnt(0)" ::: "memory"); __builtin_amdgcn_s_barrier(); asm volatile("" ::: "memory"); } while (0)

__device__ __forceinline__ f32x16 mma64(LAS const char* A, int arow, LAS const char* B, int brow, int lane) {
    const int r = lane & 31, hi = lane >> 5; f32x16 acc = {};
#pragma unroll
    for (int s = 0; s < 4; ++s) {
        const bf16x8 a = *(LAS const bf16x8*)(A + off128(arow + r, 2 * s + hi)), b = *(LAS const bf16x8*)(B + off128(brow + r, 2 * s + hi));
        acc = __builtin_amdgcn_mfma_f32_32x32x16_bf16(a, b, acc, 0, 0, 0);
    }
    return acc;
}

 constexpr int GD_R1 = 1, GD_R2 = 1, GD_R3 = 1, GD_R4 = 1;
struct GdnBufs { bf16_t* T; float* RT; bf16_t* ST; bf16_t* QT; float* OL; };

__device__ __forceinline__ void gdn_chunk(int ci, const bf16_t* zb, const float* zs, const float* convw, const float* a_log, const float* dt_bias, const GdnBufs& gb, LAS char* lds_in) {
    unsigned lb_ = (unsigned)(uintptr_t)lds_in; asm volatile("" : "+v"(lb_)); LAS char* lds = (LAS char*)(uintptr_t)lb_;
    int tid = threadIdx.x; asm volatile("" : "+v"(tid)); const int lane = tid & 63, wave = __builtin_amdgcn_readfirstlane(tid >> 6);
    const int bh = ci >> 6, c = ci & 63, b = bh >> 2, h = bh & 3;
    const size_t tok0 = (size_t)b * 4096 + c * 64;
    LAS float* sc_gc = (LAS float*)(lds + G_SC); LAS float* sc_beta = sc_gc + 64; LAS float* sc_eg = sc_gc + 128; LAS float* sc_egl = sc_gc + 192;
    LAS float* rsv = (LAS float*)(lds + G_RS);
    LAS float* part = (LAS float*)(lds + G_ATT);
    const int cg = tid % 48, rg = tid / 48, which = cg >> 4, d0 = (cg & 15) * 8, r0 = rg * 8;
    const int col = 1536 + which * 512 + h * 128 + d0, chn = which * 512 + h * 128 + d0;
#define GD_LOADW() float w[4][8]; _Pragma("unroll") for (int i = 0; i < 4; ++i) { const f32x4 a_ = *(const f32x4*)(convw + i * 1536 + chn), b_ = *(const f32x4*)(convw + i * 1536 + chn + 4); \
        w[i][0] = a_[0]; w[i][1] = a_[1]; w[i][2] = a_[2]; w[i][3] = a_[3]; w[i][4] = b_[0]; w[i][5] = b_[1]; w[i][6] = b_[2]; w[i][7] = b_[3]; }
#define GD_LOADRAW() u32x4 raw[11]; _Pragma("unroll") for (int j = 0; j < 11; ++j) { const int row_ = r0 - 3 + j; const bool ok_ = (c * 64 + row_) >= 0; \
        raw[j] = ok_ ? *(const u32x4*)(zb + (tok0 + row_) * 3584 + col) : (u32x4){0u, 0u, 0u, 0u}; }
#define GD_CONVROW(rr, y8) _Pragma("unroll") for (int e = 0; e < 8; ++e) { float a_ = 0.f; _Pragma("unroll") for (int i = 0; i < 4; ++i) { const unsigned uu = raw[(rr) + i][e >> 1]; const float xv = (e & 1) ? bfhi(uu) : bflo(uu); a_ = fmaf(w[i][e], xv, a_); } y8[e] = silu_f(a_); }
    unsigned yp[8][4];
    if (tid < 384) {
        GD_LOADW(); GD_LOADRAW();
#pragma unroll
        for (int rr = 0; rr < 8; ++rr) { float y8[8]; GD_CONVROW(rr, y8);
            yp[rr][0] = cvtpk(y8[0], y8[1]); yp[rr][1] = cvtpk(y8[2], y8[3]); yp[rr][2] = cvtpk(y8[4], y8[5]); yp[rr][3] = cvtpk(y8[6], y8[7]);
            if (which < 2) { float ss = 0.f;
#pragma unroll
                for (int e = 0; e < 8; ++e) ss += y8[e] * y8[e];
                part[(which * 64 + r0 + rr) * 16 + (cg & 15)] = ss; } }
    } else if (wave == 6) {
        const int row = lane; const float ga = zs[(tok0 + row) * 12 + 4 + h], gbv = zs[(tok0 + row) * 12 + 8 + h];
        const float xs = ga + dt_bias[h]; const float sp = xs > 20.f ? xs : log1pf(expf(xs));
        const float g = -expf(a_log[h]) * sp; const float beta = 1.f / (1.f + expf(-gbv));
        float inc = g;
#pragma unroll
        for (int o = 1; o < 64; o <<= 1) { const float t = __shfl_up(inc, o); if (lane >= o) inc += t; }
        const float gl = __shfl(inc, 63);
        sc_gc[row] = inc; sc_beta[row] = beta; sc_eg[row] = expf(inc); sc_egl[row] = expf(gl - inc);
    }
    __syncthreads();
    if (tid < 128) { const LAS float* p = part + tid * 16; float s = 0.f;
#pragma unroll
        for (int i = 0; i < 16; ++i) s += p[i];
        rsv[tid] = rsqrtf(s + 1e-6f); }
    __syncthreads();
    if (tid < 384) {
#pragma unroll
        for (int rr = 0; rr < 8; ++rr) { const int row = r0 + rr; float y8[8];
#pragma unroll
            for (int e = 0; e < 8; ++e) y8[e] = (e & 1) ? bfhi(yp[rr][e >> 1]) : bflo(yp[rr][e >> 1]);
            if (which == 0) { const float f = rsv[row] * 0.08838834764831845f;
                u32x4 o; o.x = cvtpk(y8[0] * f, y8[1] * f); o.y = cvtpk(y8[2] * f, y8[3] * f); o.z = cvtpk(y8[4] * f, y8[5] * f); o.w = cvtpk(y8[6] * f, y8[7] * f);
                *(LAS u32x4*)(lds + G_QS + off256(row, d0 >> 3)) = o;
            } else if (which == 1) { const float f = rsv[64 + row], be = sc_beta[row] * sc_eg[row], el = sc_egl[row];
                float kv[8];
#pragma unroll
                for (int e = 0; e < 8; ++e) kv[e] = y8[e] * f;
                u32x4 o; o.x = cvtpk(kv[0], kv[1]); o.y = cvtpk(kv[2], kv[3]); o.z = cvtpk(kv[4], kv[5]); o.w = cvtpk(kv[6], kv[7]);
                *(LAS u32x4*)(lds + G_K + off256(row, d0 >> 3)) = o;
                LAS float* rp = (LAS float*)(lds + G_RHS) + row * 256 + 128 + d0;
                *(LAS f32x4*)rp = (f32x4){kv[0] * be, kv[1] * be, kv[2] * be, kv[3] * be}; *(LAS f32x4*)(rp + 4) = (f32x4){kv[4] * be, kv[5] * be, kv[6] * be, kv[7] * be};
#pragma unroll
                for (int e = 0; e < 8; e += 2) { const unsigned pk = cvtpk(kv[e] * el, kv[e + 1] * el);
                    *(LAS unsigned short*)(lds + G_KGT + off128(d0 + e, rg) + rr * 2) = (unsigned short)(pk & 0xffffu);
                    *(LAS unsigned short*)(lds + G_KGT + off128(d0 + e + 1, rg) + rr * 2) = (unsigned short)(pk >> 16); }
            } else { const float be = sc_beta[row];
                LAS float* rp = (LAS float*)(lds + G_RHS) + row * 256 + d0;
                *(LAS f32x4*)rp = (f32x4){y8[0] * be, y8[1] * be, y8[2] * be, y8[3] * be}; *(LAS f32x4*)(rp + 4) = (f32x4){y8[4] * be, y8[5] * be, y8[6] * be, y8[7] * be}; }
        }
    }
#undef GD_LOADW
#undef GD_LOADRAW
#undef GD_CONVROW
    __syncthreads();
    for (int r2_ = 0; r2_ < GD_R2; ++r2_) {
        const int whichm = wave >> 2, ts = (wave >> 1) & 1, tc = wave & 1, r = lane & 31, hi = lane >> 5;
        const int cc = 32 * tc + r; const float gcc = sc_gc[cc], bec = sc_beta[cc];
        f32x16 acc = {};
        const bool live = tc >= ts;
        if (live) {
            LAS const char* Xi = lds + (whichm ? G_QS : G_K);
#pragma unroll
            for (int s8 = 0; s8 < 8; ++s8) {
                const bf16x8 a = *(LAS const bf16x8*)(lds + G_K + off256(32 * ts + r, 2 * s8 + hi)), bb = *(LAS const bf16x8*)(Xi + off256(cc, 2 * s8 + hi));
                acc = __builtin_amdgcn_mfma_f32_32x32x16_bf16(a, bb, acc, 0, 0, 0); }
        }
        if (whichm == 0) {
            if (live) {
#pragma unroll
                for (int g = 0; g < 4; ++g) { const int s4 = 32 * ts + 8 * g + 4 * hi; const f32x4 gs = *(LAS const f32x4*)(sc_gc + s4); f32x4 o;
#pragma unroll
                    for (int j = 0; j < 4; ++j) o[j] = (cc > s4 + j) ? bec * acc[4 * g + j] * __expf(gcc - gs[j]) : 0.f;
                    *(LAS f32x4*)(lds + G_M + cc * 256 + s4 * 4) = o; }
            }
        } else {
#pragma unroll
            for (int g = 0; g < 4; ++g) { const int s4 = 32 * ts + 8 * g + 4 * hi; const f32x4 gs = *(LAS const f32x4*)(sc_gc + s4); float o[4];
#pragma unroll
                for (int j = 0; j < 4; ++j) o[j] = (live && cc >= s4 + j) ? acc[4 * g + j] * __expf(gcc - gs[j]) : 0.f;
                u32x2 w2; w2.x = cvtpk(o[0], o[1]); w2.y = cvtpk(o[2], o[3]);
                *(LAS u32x2*)(lds + G_ATT + off128(cc, s4 >> 3) + (s4 & 7) * 2) = w2; }
        }
    }
    __syncthreads();
    if (wave < 4) {
        float x[64];
        const LAS float* rhs = (const LAS float*)(lds + G_RHS) + tid; const LAS float* Mm = (const LAS float*)(lds + G_M);
        f32x4 mA[16], mB[16];
#define GD_LDM(buf, row_) { _Pragma("unroll") for (int q_ = 0; q_ < ((row_) + 3) / 4; ++q_) buf[q_] = *(const LAS f32x4*)(Mm + (row_) * 64 + 4 * q_); }
#define GD_ROW(buf, row_) { float a0 = rhs[(row_) * 256], a1 = 0.f, a2 = 0.f, a3 = 0.f; \
            _Pragma("unroll") for (int q_ = 0; q_ < (row_) / 4; ++q_) { a0 = fmaf(-buf[q_][0], x[4 * q_], a0); a1 = fmaf(-buf[q_][1], x[4 * q_ + 1], a1); a2 = fmaf(-buf[q_][2], x[4 * q_ + 2], a2); a3 = fmaf(-buf[q_][3], x[4 * q_ + 3], a3); \
                asm("" : "+v"(a0), "+v"(a1), "+v"(a2), "+v"(a3)); } \
            if (((row_) & 3) > 0) a0 = fmaf(-buf[(row_) / 4][0], x[((row_) & ~3)], a0); \
            if (((row_) & 3) > 1) a1 = fmaf(-buf[(row_) / 4][1], x[((row_) & ~3) + 1], a1); \
            if (((row_) & 3) > 2) a2 = fmaf(-buf[(row_) / 4][2], x[((row_) & ~3) + 2], a2); \
            x[row_] = (a0 + a1) + (a2 + a3); }
        for (int r3_ = 0; r3_ < GD_R3; ++r3_) {
        GD_LDM(mA, 0);
#pragma clang loop unroll(full)
        for (int cr = 0; cr < 64; cr += 2) {
            GD_LDM(mB, cr + 1); asm volatile("" ::: "memory");
            GD_ROW(mA, cr); asm volatile("" ::: "memory");
            if (cr + 2 < 64) { GD_LDM(mA, cr + 2); } asm volatile("" ::: "memory");
            GD_ROW(mB, cr + 1); asm volatile("" ::: "memory");
        }
        }
#undef GD_LDM
#undef GD_ROW
        __syncthreads();
        LAS char* dst = lds + (tid < 128 ? G_K : G_M); const int colr = tid & 127;
#pragma unroll
        for (int ch = 0; ch < 8; ++ch) { u32x4 o; o.x = cvtpk(x[8 * ch], x[8 * ch + 1]); o.y = cvtpk(x[8 * ch + 2], x[8 * ch + 3]); o.z = cvtpk(x[8 * ch + 4], x[8 * ch + 5]); o.w = cvtpk(x[8 * ch + 6], x[8 * ch + 7]);
            *(LAS u32x4*)(dst + off128(colr, ch)) = o; }
    } else { __syncthreads(); }
    __syncthreads();
    for (int r4_ = 0; r4_ < GD_R4; ++r4_) {
    {
        LAS const char* UT = lds + G_K; LAS const char* WT = lds + G_M; LAS const char* KGT = lds + G_KGT; LAS const char* ATT = lds + G_ATT;
        const int r = lane & 31, hi = lane >> 5;
        const float gl = sc_eg[63];
        {
            const int dt = wave >> 1, tt = wave & 1, tok = 32 * tt + r; const float eg = sc_eg[tok];
            const f32x16 acc = mma64(WT, 32 * dt, ATT, 32 * tt, lane);
#pragma unroll
            for (int g = 0; g < 4; ++g) { const int d4 = 32 * dt + 8 * g + 4 * hi; bf16_t* qrow = gb.QT + (((size_t)ci * 32 + (d4 >> 2)) * 64 + tok) * 4 - d4;
                const u32x2 q2 = *(LAS const u32x2*)(lds + G_QS + off256(tok, d4 >> 3) + (d4 & 7) * 2);
                u32x2 o; o.x = cvtpk(bflo(q2.x) * eg - acc[4 * g], bfhi(q2.x) * eg - acc[4 * g + 1]); o.y = cvtpk(bflo(q2.y) * eg - acc[4 * g + 2], bfhi(q2.y) * eg - acc[4 * g + 3]);
                *(u32x2*)(qrow + d4) = o; }
        }
        {
            const int dt = wave >> 1, tt = wave & 1, tok = 32 * tt + r;
            const f32x16 acc = mma64(UT, 32 * dt, ATT, 32 * tt, lane);
#pragma unroll
            for (int g = 0; g < 4; ++g) { const int dg = 8 * dt + 2 * g + hi; *(f32x4*)(gb.OL + (((size_t)ci * 32 + dg) * 64 + tok) * 4) = (f32x4){acc[4 * g], acc[4 * g + 1], acc[4 * g + 2], acc[4 * g + 3]}; }
        }
#pragma unroll
        for (int i2 = 0; i2 < 2; ++i2) {
            const int id = wave + 8 * i2, kt = id >> 2, it = id & 3, irow = 32 * it + r;
            const f32x16 acc = mma64(WT, 32 * kt, KGT, 32 * it, lane);
#pragma unroll
            for (int g = 0; g < 4; ++g) { const int k4 = 32 * kt + 8 * g + 4 * hi; float o[4];
#pragma unroll
                for (int j = 0; j < 4; ++j) o[j] = ((irow == k4 + j) ? gl : 0.f) - acc[4 * g + j];
                u32x2 w2; w2.x = cvtpk(o[0], o[1]); w2.y = cvtpk(o[2], o[3]);
                const int pg = 4 * (2 * kt + (g >> 1)) + 2 * hi + (g & 1); *(u32x2*)(gb.T + (((size_t)ci * 32 + pg) * 128 + irow) * 4) = w2; }
        }
#pragma unroll
        for (int i2 = 0; i2 < 2; ++i2) {
            const int id = wave + 8 * i2, it = id >> 2, jt = id & 3, jcol = 32 * jt + r;
            const f32x16 acc = mma64(KGT, 32 * it, UT, 32 * jt, lane);
#pragma unroll
            for (int g = 0; g < 4; ++g) { const int ig = 8 * it + 2 * g + hi; *(f32x4*)(gb.RT + (((size_t)ci * 32 + ig) * 128 + jcol) * 4) = (f32x4){acc[4 * g], acc[4 * g + 1], acc[4 * g + 2], acc[4 * g + 3]}; }
        }
    }
    }
    GD_BAR();
}

__device__ __forceinline__ void gdn_scan(int bh, int half, const GdnBufs& gb, LAS char* lds) {
    int tid = threadIdx.x; asm volatile("" : "+v"(tid)); const int lane = tid & 63, wave = __builtin_amdgcn_readfirstlane(tid >> 6), r = lane & 31, hi = lane >> 5;
    constexpr int TBS = 32768, RB = 2 * TBS, RBS = 16384;
    if (wave >= 4) {
        const int t = tid - 256;
        u32x4 stA[8], stB[8]; f32x4 srA[4], srB[4]; const unsigned toff = (unsigned)t * 16u;
        const unsigned roff = (unsigned)(((t >> 5) * 128 + 32 * half + (t & 31)) * 16);
        const bf16_t* T0 = gb.T + (size_t)(bh * 64) * 16384; const float* R0 = gb.RT + (size_t)(bh * 64) * 16384;
#define GD_LT(st, c_) { const char* p_ = (const char*)(T0 + (size_t)(c_) * 16384); _Pragma("unroll") for (int n = 0; n < 8; ++n) st[n] = *(const u32x4*)(p_ + n * 4096 + toff); }
#define GD_WT(st, c_) { LAS char* q_ = lds + ((c_) & 1) * TBS + toff; _Pragma("unroll") for (int n = 0; n < 8; ++n) *(LAS u32x4*)(q_ + n * 4096) = st[n]; }
#define GD_LR(sr, c_) { const char* p_ = (const char*)(R0 + (size_t)(c_) * 16384); _Pragma("unroll") for (int n = 0; n < 4; ++n) sr[n] = *(const f32x4*)(p_ + n * 16384 + roff); }
#define GD_WR(sr, c_) { LAS char* q_ = lds + RB + ((c_) & 1) * RBS + toff; _Pragma("unroll") for (int n = 0; n < 4; ++n) *(LAS f32x4*)(q_ + n * 4096) = sr[n]; }
        GD_LT(stA, 0); GD_LR(srA, 0); GD_WT(stA, 0); GD_WR(srA, 0); GD_LT(stA, 1); GD_LR(srA, 1); GD_LT(stB, 2); GD_LR(srB, 2);
        for (int c = 0; c < 64; c += 2) {
            GD_BAR();
            GD_WT(stA, c + 1); GD_WR(srA, c + 1); if (c + 3 < 64) { GD_LT(stA, c + 3); GD_LR(srA, c + 3); }
            GD_BAR();
            if (c + 2 < 64) { GD_WT(stB, c + 2); GD_WR(srB, c + 2); if (c + 4 < 64) { GD_LT(stB, c + 4); GD_LR(srB, c + 4); } }
        }
#undef GD_LT
#undef GD_WT
#undef GD_LR
#undef GD_WR
    } else if (wave >= 1) {
        for (int c = 0; c < 64; ++c) { GD_BAR(); }
    } else {
        f32x16 S[4] = {};
        const int col = 32 * half + r;
        for (int c = 0; c < 64; ++c) {
            const int ci = bh * 64 + c;
            bf16_t* stb = gb.ST + ((size_t)ci * 32 * 128 + col) * 4;
            bf16x8 bfr[4][2];
#pragma unroll
            for (int tl = 0; tl < 4; ++tl)
#pragma unroll
                for (int s = 0; s < 2; ++s) { u32x4 w4; w4.x = cvtpk(S[tl][8 * s], S[tl][8 * s + 1]); w4.y = cvtpk(S[tl][8 * s + 2], S[tl][8 * s + 3]); w4.z = cvtpk(S[tl][8 * s + 4], S[tl][8 * s + 5]); w4.w = cvtpk(S[tl][8 * s + 6], S[tl][8 * s + 7]);
                    bfr[tl][s] = *reinterpret_cast<bf16x8*>(&w4);
                    u32x2 lo2; lo2.x = w4.x; lo2.y = w4.y; u32x2 hi2; hi2.x = w4.z; hi2.y = w4.w;
                    *(u32x2*)(stb + (size_t)(8 * tl + 4 * s + hi) * 512) = lo2; *(u32x2*)(stb + (size_t)(8 * tl + 4 * s + hi + 2) * 512) = hi2; }
            GD_BAR();
            LAS const char* Tb = lds + (c & 1) * TBS + (2 * hi * 128 + r) * 8;
            LAS const char* Rb = lds + RB + (c & 1) * RBS + (hi * 32 + r) * 16;
            bf16x8 afA[8], afB[8]; f32x4 rvA[4], rvB[4];
#define GD_LDT(af, rv, it_) { _Pragma("unroll") for (int q = 0; q < 8; ++q) { const u32x2 l_ = *(LAS const u32x2*)(Tb + q * 4096 + (it_) * 256), h_ = *(LAS const u32x2*)(Tb + q * 4096 + (it_) * 256 + 1024); \
                                  u32x4 w_; w_.x = l_.x; w_.y = l_.y; w_.z = h_.x; w_.w = h_.y; af[q] = *reinterpret_cast<bf16x8*>(&w_); } \
                              _Pragma("unroll") for (int g = 0; g < 4; ++g) rv[g] = *(LAS const f32x4*)(Rb + (8 * (it_) + 2 * g) * 512); }
#define GD_MMT(af, rv, it_) { f32x16 acc = {}; _Pragma("unroll") for (int q = 0; q < 8; ++q) acc = __builtin_amdgcn_mfma_f32_32x32x16_bf16(af[q], bfr[q >> 1][q & 1], acc, 0, 0, 0); \
                              _Pragma("unroll") for (int g = 0; g < 4; ++g) _Pragma("unroll") for (int j = 0; j < 4; ++j) S[it_][4 * g + j] = acc[4 * g + j] + rv[g][j]; }
            GD_LDT(afA, rvA, 0); __builtin_amdgcn_sched_barrier(0);
            GD_LDT(afB, rvB, 1); __builtin_amdgcn_sched_barrier(0);
            GD_MMT(afA, rvA, 0); __builtin_amdgcn_sched_barrier(0);
            GD_LDT(afA, rvA, 2); __builtin_amdgcn_sched_barrier(0);
            GD_MMT(afB, rvB, 1); __builtin_amdgcn_sched_barrier(0);
            GD_LDT(afB, rvB, 3); __builtin_amdgcn_sched_barrier(0);
            GD_MMT(afA, rvA, 2); __builtin_amdgcn_sched_barrier(0);
            GD_MMT(afB, rvB, 3);
#undef GD_LDT
#undef GD_MMT
        }
    }
    GD_BAR();
}

__device__ __forceinline__ void gdn_out(int ci, const GdnBufs& gb, const bf16_t* zb, const float* onorm, bf16_t* mix, LAS char* lds) {
    int tid = threadIdx.x; asm volatile("" : "+v"(tid)); const int lane = tid & 63, wave = __builtin_amdgcn_readfirstlane(tid >> 6), r = lane & 31, hi = lane >> 5;
    const int bh = ci >> 6, c = ci & 63, b = bh >> 2, h = bh & 3;
    const int dt = wave >> 1, tt = wave & 1, tok = 32 * tt + r;
    const size_t m = (size_t)b * 4096 + c * 64 + tok;
    LAS float* ssq = (LAS float*)lds;
    const bf16_t* Ab = gb.ST + ((size_t)ci * 32 * 128 + 32 * dt + r) * 4;
    const bf16_t* Bb = gb.QT + ((size_t)ci * 32 * 64 + tok) * 4;
    const float* Ob = gb.OL + ((size_t)ci * 32 * 64 + tok) * 4;
    f32x16 acc;
#pragma unroll
    for (int g = 0; g < 4; ++g) { const f32x4 v = *(const f32x4*)(Ob + (size_t)(8 * dt + 2 * g + hi) * 256); acc[4 * g] = v[0]; acc[4 * g + 1] = v[1]; acc[4 * g + 2] = v[2]; acc[4 * g + 3] = v[3]; }
#pragma unroll
    for (int s = 0; s < 8; ++s) { const int kg = 4 * s + 2 * hi;
        const u32x2 a0 = *(const u32x2*)(Ab + (size_t)kg * 512), a1 = *(const u32x2*)(Ab + (size_t)(kg + 1) * 512), b0 = *(const u32x2*)(Bb + (size_t)kg * 256), b1 = *(const u32x2*)(Bb + (size_t)(kg + 1) * 256);
        u32x4 aw; aw.x = a0.x; aw.y = a0.y; aw.z = a1.x; aw.w = a1.y; u32x4 bw; bw.x = b0.x; bw.y = b0.y; bw.z = b1.x; bw.w = b1.y;
        acc = __builtin_amdgcn_mfma_f32_32x32x16_bf16(*reinterpret_cast<bf16x8*>(&aw), *reinterpret_cast<bf16x8*>(&bw), acc, 0, 0, 0); }
    float ss = 0.f;
#pragma unroll
    for (int i = 0; i < 16; ++i) ss += acc[i] * acc[i];
    { auto rr = __builtin_amdgcn_permlane32_swap(__float_as_uint(ss), __float_as_uint(ss), false, false); ss = __uint_as_float(rr[0]) + __uint_as_float(rr[1]); }
    if (hi == 0) ssq[tok * 4 + dt] = ss;
    __syncthreads();
    const f32x4 s4 = *(LAS const f32x4*)(ssq + tok * 4);
    const float rs = rsqrtf(((s4[0] + s4[1]) + (s4[2] + s4[3])) * (1.f / 128.f) + 1e-6f);
    const bf16_t* grow = zb + m * 3584 + 3072 + h * 128; bf16_t* mrow = mix + m * 1024 + 512 + h * 128;
#pragma unroll
    for (int g = 0; g < 4; ++g) { const int d4 = 32 * dt + 8 * g + 4 * hi;
        const u32x2 g2 = *(const u32x2*)(grow + d4); const f32x4 on = *(const f32x4*)(onorm + d4);
        const float o0 = acc[4 * g] * rs * on[0] * silu_f(bflo(g2.x)), o1 = acc[4 * g + 1] * rs * on[1] * silu_f(bfhi(g2.x)), o2 = acc[4 * g + 2] * rs * on[2] * silu_f(bflo(g2.y)), o3 = acc[4 * g + 3] * rs * on[3] * silu_f(bfhi(g2.y));
        u32x2 w2; w2.x = cvtpk(o0, o1); w2.y = cvtpk(o2, o3); *(u32x2*)(mrow + d4) = w2; }
    GD_BAR();
}
#undef GD_BAR
#undef LAS
}
namespace mk {
#define LAS __attribute__((address_space(3)))
#define GAS __attribute__((address_space(1)))
typedef unsigned short bf16_t;
typedef short bf16x8 __attribute__((ext_vector_type(8)));
typedef float f32x4 __attribute__((ext_vector_type(4)));
typedef float f32x2 __attribute__((ext_vector_type(2)));
typedef unsigned u32x4 __attribute__((ext_vector_type(4)));
typedef unsigned u32x2 __attribute__((ext_vector_type(2)));
constexpr int BM = 256, BK = 64, HALF = 128, HTB = HALF * BK * 2, STAGE_BYTES = 8 * HTB, NXCD = 8, WGM = 8;
constexpr int NWAVES = 8;
constexpr int T_ = 16384, D_ = 1024;
constexpr int ECAP = 16384;

__host__ __device__ __forceinline__ int lds_byte(int r, int c) { const int st = (r >> 4) * 2 + (c >> 5), rr = r & 15, cc = c & 31, ob = rr * 64 + cc * 2; return st * 1024 + (ob ^ (((ob >> 9) & 1) << 5)); }
__host__ __device__ __forceinline__ void stage_rc(int b, int& R, int& C) { const int st = b / 1024, sb = b % 1024, swz = sb ^ (((sb >> 9) & 1) << 5); R = (st >> 1) * 16 + swz / 64; C = (st & 1) * 32 + (swz % 64) / 2; }
__host__ __device__ __forceinline__ int perm32(int rho) { const int n = rho >> 4, i = rho & 15; return 8 * (i >> 2) + 4 * n + (i & 3); }
__device__ __forceinline__ unsigned cvt_pk_bf16(float lo, float hi) { unsigned r; asm volatile("v_cvt_pk_bf16_f32 %0, %1, %2" : "=v"(r) : "v"(lo), "v"(hi)); return r; }
__device__ __forceinline__ unsigned pk4_fp8(float a, float b, float c, float d) { unsigned w = 0; w = __builtin_amdgcn_cvt_pk_fp8_f32(a, b, w, false); w = __builtin_amdgcn_cvt_pk_fp8_f32(c, d, w, true); return w; }
__device__ __forceinline__ float bf2f(unsigned short b) { return __uint_as_float(((unsigned)b) << 16); }
__device__ __forceinline__ float silu_f(float x) { return x * __builtin_amdgcn_rcpf(1.f + __builtin_amdgcn_exp2f(-1.4426950408889634f * x)); }
__device__ __forceinline__ f32x2 swiglu_pk(f32x2 g, f32x2 u, float s) {
    const f32x2 t = g * (-1.4426950408889634f); f32x2 e; e.x = __builtin_amdgcn_exp2f(t.x); e.y = __builtin_amdgcn_exp2f(t.y);
    const f32x2 d = e + 1.0f; f32x2 r; r.x = __builtin_amdgcn_rcpf(d.x); r.y = __builtin_amdgcn_rcpf(d.y);
    return (g * r) * (u * s);
}
#define DPP_F(old_, v_, ctrl_, rmask_) __int_as_float(__builtin_amdgcn_update_dpp(__float_as_int(old_), __float_as_int(v_), ctrl_, rmask_, 0xf, false))
__device__ __forceinline__ float wave_sum(float v) {
    v += DPP_F(0.f, v, 0xb1, 0xf);
    v += DPP_F(0.f, v, 0x4e, 0xf);
    v += DPP_F(0.f, v, 0x141, 0xf);
    v += DPP_F(0.f, v, 0x140, 0xf);
    v += DPP_F(0.f, v, 0x142, 0xa);
    v += DPP_F(0.f, v, 0x143, 0xc);
    return __int_as_float(__builtin_amdgcn_readlane(__float_as_int(v), 63));
}

struct Unit { int pm, pn, po, rows, e, mt; };

struct DenseOrder {
    int nM, nN, nwg, G, c;
    __device__ void init(int M, int N, int G_, int c_) { nM = M / BM; nN = N / BM; nwg = nM * nN; G = G_; c = c_; }
    __device__ bool next(int i, Unit& u) const {
        const long L = (long)i * G + c; if (L >= nwg) return false;
        int wgid = (int)L; { const int q = nwg / NXCD, r = nwg % NXCD, xcd = wgid % NXCD, off = wgid / NXCD; wgid = (xcd < r ? xcd * (q + 1) : r * (q + 1) + (xcd - r) * q) + off; }
        const int nig = WGM * nN, gid = wgid / nig, fm = gid * WGM, gsz = (nM - fm) < WGM ? (nM - fm) : WGM;
        u.pm = fm + ((wgid % nig) % gsz); u.pn = (wgid % nig) / gsz; u.po = u.pn; u.rows = 256; u.e = 0; u.mt = 0; return true;
    }
    __device__ __forceinline__ int arow(const Unit& u, int r) const { return u.pm * BM + r; }
};
struct MoeOrder {
    int nN, G, c; const int* cnt; const int* idx;
    __device__ bool next(int i, Unit& u) const {
        int cj[8]; int nM = 0;
#pragma unroll
        for (int j = 0; j < 8; ++j) { cj[j] = __hip_atomic_load(cnt + j, __ATOMIC_RELAXED, __HIP_MEMORY_SCOPE_AGENT); nM += (cj[j] + 255) >> 8; }
        const long L = (long)i * G + c; if (L >= (long)nM * nN) return false;
        const int nig = WGM * nN, gid = (int)(L / nig), fm = gid * WGM, gsz = (nM - fm) < WGM ? (nM - fm) : WGM, w = (int)(L % nig);
        const int pmg = fm + (w % gsz), pnl = w / gsz;
        int t = pmg, e = 0, rows = 0; bool found = false;
#pragma unroll
        for (int j = 0; j < 8; ++j) { const int ntj = (cj[j] + 255) >> 8; if (!found) { if (t < ntj) { found = true; e = j; const int rem = cj[j] - t * 256; rows = rem < 256 ? rem : 256; } else t -= ntj; } }
        u.pm = pmg; u.e = e; u.mt = t; u.pn = e * nN + pnl; u.po = pnl; u.rows = rows; return true;
    }
    __device__ __forceinline__ int arow(const Unit& u, int r) const {
        if (idx) return r < u.rows ? (idx[u.e * ECAP + u.mt * 256 + r] >> 1) : 0;
        return u.pm * BM + r;
    }
};

struct EpiBf16 {
    static constexpr bool PERM = true;
    bf16_t* O; int ldc;
    __device__ __forceinline__ void operator()(const f32x4 (&acc)[2][2][4][2], const Unit& u, int wr, int wc, int fr, int fq) const {
        const int row0 = u.pm * BM + wr * 64 + fr, col0 = u.po * BM + wc * 32 + 8 * fq;
#pragma unroll
        for (int ai = 0; ai < 2; ++ai)
#pragma unroll
            for (int m = 0; m < 4; ++m) { bf16_t* rowp = O + (size_t)(row0 + ai * HALF + m * 16) * ldc + col0;
#pragma unroll
                for (int bj = 0; bj < 2; ++bj) { const f32x4 v0 = acc[ai][bj][m][0], v1 = acc[ai][bj][m][1];
                    u32x4 w; w.x = cvt_pk_bf16(v0[0], v0[1]); w.y = cvt_pk_bf16(v0[2], v0[3]); w.z = cvt_pk_bf16(v1[0], v1[1]); w.w = cvt_pk_bf16(v1[2], v1[3]);
                    *(u32x4*)(rowp + bj * HALF) = w; } }
    }
};
struct EpiResF32 {
    static constexpr bool PERM = false;
    float* C; const float* res; int ldc;
    __device__ __forceinline__ void operator()(const f32x4 (&acc)[2][2][4][2], const Unit& u, int wr, int wc, int fr, int fq) const {
        const int row0 = u.pm * BM + wr * 64 + fr, col0 = u.po * BM + wc * 32 + 4 * fq;
#pragma unroll
        for (int ai = 0; ai < 2; ++ai)
#pragma unroll
            for (int m = 0; m < 4; ++m) { const size_t off = (size_t)(row0 + ai * HALF + m * 16) * ldc + col0;
#pragma unroll
                for (int bj = 0; bj < 2; ++bj)
#pragma unroll
                    for (int n = 0; n < 2; ++n) { const f32x4 r = *(const f32x4*)(res + off + bj * HALF + n * 16); *(f32x4*)(C + off + bj * HALF + n * 16) = acc[ai][bj][m][n] + r; }
                asm volatile("" ::: "memory"); }
    }
};
template <bool RES_BF16> struct EpiResB {
    static constexpr bool PERM = true;
    bf16_t* O; const void* res; int ldc;
    __device__ __forceinline__ void operator()(const f32x4 (&acc)[2][2][4][2], const Unit& u, int wr, int wc, int fr, int fq) const {
        const int row0 = u.pm * BM + wr * 64 + fr, col0 = u.po * BM + wc * 32 + 8 * fq;
#pragma unroll
        for (int ai = 0; ai < 2; ++ai)
#pragma unroll
            for (int m = 0; m < 4; ++m) { const size_t off = (size_t)(row0 + ai * HALF + m * 16) * ldc + col0;
#pragma unroll
                for (int bj = 0; bj < 2; ++bj) { f32x4 v0 = acc[ai][bj][m][0], v1 = acc[ai][bj][m][1];
                    if (RES_BF16) { const u32x4 r = *(const u32x4*)((const bf16_t*)res + off + bj * HALF);
                        v0[0] += __uint_as_float(r.x << 16); v0[1] += __uint_as_float(r.x & 0xffff0000u); v0[2] += __uint_as_float(r.y << 16); v0[3] += __uint_as_float(r.y & 0xffff0000u);
                        v1[0] += __uint_as_float(r.z << 16); v1[1] += __uint_as_float(r.z & 0xffff0000u); v1[2] += __uint_as_float(r.w << 16); v1[3] += __uint_as_float(r.w & 0xffff0000u); }
                    else { const float* rp = (const float*)res + off + bj * HALF; v0 += *(const f32x4*)rp; v1 += *(const f32x4*)(rp + 4); }
                    u32x4 w; w.x = cvt_pk_bf16(v0[0], v0[1]); w.y = cvt_pk_bf16(v0[2], v0[3]); w.z = cvt_pk_bf16(v1[0], v1[1]); w.w = cvt_pk_bf16(v1[2], v1[3]);
                    *(u32x4*)(O + off + bj * HALF) = w; }
                asm volatile("" ::: "memory"); }
    }
};
struct EpiSwiglu {
    static constexpr bool PERM = true;
    bf16_t* O; int ldo;
    __device__ __forceinline__ void operator()(const f32x4 (&acc)[2][2][4][2], const Unit& u, int wr, int wc, int fr, int fq) const {
        const int row0 = u.pm * BM + wr * 64 + fr, col0 = u.po * HALF + wc * 32 + 8 * fq;
#pragma unroll
        for (int ai = 0; ai < 2; ++ai)
#pragma unroll
            for (int m = 0; m < 4; ++m) { bf16_t* rowp = O + (size_t)(row0 + ai * HALF + m * 16) * ldo + col0;
                const f32x4 g0 = acc[ai][0][m][0], g1 = acc[ai][0][m][1], u0 = acc[ai][1][m][0], u1 = acc[ai][1][m][1];
                float v[8];
#pragma unroll
                for (int j = 0; j < 4; j += 2) { const f32x2 a = swiglu_pk((f32x2){g0[j], g0[j + 1]}, (f32x2){u0[j], u0[j + 1]}, 1.f), b = swiglu_pk((f32x2){g1[j], g1[j + 1]}, (f32x2){u1[j], u1[j + 1]}, 1.f);
                    v[j] = a.x; v[j + 1] = a.y; v[4 + j] = b.x; v[5 + j] = b.y; }
                u32x4 w; w.x = cvt_pk_bf16(v[0], v[1]); w.y = cvt_pk_bf16(v[2], v[3]); w.z = cvt_pk_bf16(v[4], v[5]); w.w = cvt_pk_bf16(v[6], v[7]);
                *(u32x4*)rowp = w; }
    }
};
struct EpiSwiglu8 {
    static constexpr bool PERM = true;
    unsigned char* O; int ldo; float oscale;
    __device__ __forceinline__ void operator()(const f32x4 (&acc)[2][2][4][2], const Unit& u, int wr, int wc, int fr, int fq) const {
        const int row0 = u.pm * BM + wr * 64 + fr, col0 = u.po * HALF + wc * 32 + 8 * fq;
#pragma unroll
        for (int ai = 0; ai < 2; ++ai)
#pragma unroll
            for (int m = 0; m < 4; ++m) { unsigned char* rowp = O + (size_t)(row0 + ai * HALF + m * 16) * ldo + col0;
                const f32x4 g0 = acc[ai][0][m][0], g1 = acc[ai][0][m][1], u0 = acc[ai][1][m][0], u1 = acc[ai][1][m][1];
                float v[8];
#pragma unroll
                for (int j = 0; j < 4; j += 2) { const f32x2 a = swiglu_pk((f32x2){g0[j], g0[j + 1]}, (f32x2){u0[j], u0[j + 1]}, oscale), b = swiglu_pk((f32x2){g1[j], g1[j + 1]}, (f32x2){u1[j], u1[j + 1]}, oscale);
                    v[j] = a.x; v[j + 1] = a.y; v[4 + j] = b.x; v[5 + j] = b.y; }
                u32x2 w; w.x = pk4_fp8(v[0], v[1], v[2], v[3]); w.y = pk4_fp8(v[4], v[5], v[6], v[7]);
                *(u32x2*)rowp = w; }
    }
};
struct EpiQkvMoba {
    static constexpr bool PERM = true, AFTER_DRAIN = false;
    bf16_t* O; const float* qg; const float* kg; const float* ropec; const float* ropes; float* kmean; LAS unsigned char* xl;
    __device__ __forceinline__ void operator()(const f32x4 (&acc)[2][2][4][2], const Unit& u, int wr, int wc, int fr, int fq) const {
        const int t = u.po;
        if (t >= 8) {
            const int row0 = u.pm * BM + wr * 64 + fr, col0 = t * BM + wc * 32 + 8 * fq;
#pragma unroll
            for (int ai = 0; ai < 2; ++ai)
#pragma unroll
                for (int m = 0; m < 4; ++m) { bf16_t* rowp = O + (size_t)(row0 + ai * HALF + m * 16) * 3072 + col0;
#pragma unroll
                    for (int bj = 0; bj < 2; ++bj) { const f32x4 v0 = acc[ai][bj][m][0], v1 = acc[ai][bj][m][1];
                        u32x4 w; w.x = cvt_pk_bf16(v0[0], v0[1]); w.y = cvt_pk_bf16(v0[2], v0[3]); w.z = cvt_pk_bf16(v1[0], v1[1]); w.w = cvt_pk_bf16(v1[2], v1[3]);
                        *(u32x4*)(rowp + bj * HALF) = w; } }
            return;
        }
        LAS float* P = (LAS float*)xl;
        LAS float* ks = (LAS float*)(xl + 4096);
        int tid = threadIdx.x; asm volatile("" : "+v"(tid)); const bool isk = t >= 4;
        if (tid < 256) ks[tid] = 0.f;
        LAS float* gl_ = (LAS float*)(xl + 5120);
        if (tid < 128) gl_[tid] = (isk ? kg : qg)[tid];
#pragma unroll
        for (int ai = 0; ai < 2; ++ai)
#pragma unroll
            for (int m = 0; m < 4; ++m) { float ss = 0.f;
#pragma unroll
                for (int bj = 0; bj < 2; ++bj)
#pragma unroll
                    for (int n = 0; n < 2; ++n) { const f32x4 v = acc[ai][bj][m][n]; ss += (v[0] * v[0] + v[1] * v[1]) + (v[2] * v[2] + v[3] * v[3]); }
                ss += __shfl_xor(ss, 16); ss += __shfl_xor(ss, 32);
                if (fq == 0) P[(ai * HALF + wr * 64 + m * 16 + fr) * 4 + wc] = ss; }
        asm volatile("s_waitcnt lgkmcnt(0)" ::: "memory"); __builtin_amdgcn_s_barrier(); asm volatile("" ::: "memory");
        const int hs = wc >> 1, dl0 = 32 * (wc & 1) + 8 * fq;
#pragma unroll
        for (int ai = 0; ai < 2; ++ai)
#pragma unroll
            for (int m = 0; m < 4; ++m) { const int rl = ai * HALF + wr * 64 + m * 16 + fr, row = u.pm * BM + rl, pos = row & 4095;
                const float rs = rsqrtf((P[rl * 4 + 2 * hs] + P[rl * 4 + 2 * hs + 1]) * (1.f / 128.f) + 1e-6f);
                u32x4 wl, wh;
#pragma unroll
                for (int q4 = 0; q4 < 2; ++q4) {
                    const f32x4 cs = *(const f32x4*)(ropec + pos * 64 + dl0 + 4 * q4), sn = *(const f32x4*)(ropes + pos * 64 + dl0 + 4 * q4);
                    const f32x4 ga = *(const LAS f32x4*)(gl_ + dl0 + 4 * q4), gb = *(const LAS f32x4*)(gl_ + 64 + dl0 + 4 * q4);
                    const f32x4 a = acc[ai][0][m][q4] * rs * ga, b = acc[ai][1][m][q4] * rs * gb;
                    const f32x4 lo = a * cs - b * sn, hi = b * cs + a * sn;
                    if (q4 == 0) { wl.x = cvt_pk_bf16(lo[0], lo[1]); wl.y = cvt_pk_bf16(lo[2], lo[3]); wh.x = cvt_pk_bf16(hi[0], hi[1]); wh.y = cvt_pk_bf16(hi[2], hi[3]); }
                    else { wl.z = cvt_pk_bf16(lo[0], lo[1]); wl.w = cvt_pk_bf16(lo[2], lo[3]); wh.z = cvt_pk_bf16(hi[0], hi[1]); wh.w = cvt_pk_bf16(hi[2], hi[3]); }
                    asm volatile("" ::: "memory"); }
                bf16_t* rowp = O + (size_t)row * 3072 + t * BM + hs * 128 + dl0;
                *(u32x4*)rowp = wl; *(u32x4*)(rowp + 64) = wh;
                asm volatile("" ::: "memory"); }
        if (isk) {
            asm volatile("s_waitcnt vmcnt(0)" ::: "memory"); __builtin_amdgcn_s_barrier(); asm volatile("" ::: "memory");
            const int c8 = tid & 31, rg = tid >> 5; float cs8[8];
#pragma unroll
            for (int e = 0; e < 8; ++e) cs8[e] = 0.f;
            const bf16_t* src = O + (size_t)(u.pm * BM + rg * 16) * 3072 + t * BM + c8 * 8;
#pragma unroll
            for (int r = 0; r < 16; ++r) { const u32x4 raw = *(const u32x4*)(src + (size_t)r * 3072);
                cs8[0] += __uint_as_float(raw.x << 16); cs8[1] += __uint_as_float(raw.x & 0xffff0000u); cs8[2] += __uint_as_float(raw.y << 16); cs8[3] += __uint_as_float(raw.y & 0xffff0000u);
                cs8[4] += __uint_as_float(raw.z << 16); cs8[5] += __uint_as_float(raw.z & 0xffff0000u); cs8[6] += __uint_as_float(raw.w << 16); cs8[7] += __uint_as_float(raw.w & 0xffff0000u); }
#pragma unroll
            for (int e = 0; e < 8; ++e) atomicAdd((float*)(ks + c8 * 8 + e), cs8[e]);
            asm volatile("s_waitcnt lgkmcnt(0)" ::: "memory"); __builtin_amdgcn_s_barrier(); asm volatile("" ::: "memory");
            if (tid < 256) { const int head = (t - 4) * 2 + (tid >> 7), b = u.pm >> 4, blk = u.pm & 15;
                kmean[(((size_t)b * 8 + head) * 16 + blk) * 128 + (tid & 127)] = ks[tid] * (1.f / 256.f); }
        }
    }
};
struct EpiMoeOut {
    static constexpr bool PERM = true;
    bf16_t* Y; const int* idx;
    __device__ __forceinline__ void operator()(const f32x4 (&acc)[2][2][4][2], const Unit& u, int wr, int wc, int fr, int fq) const {
        const int col0 = u.po * BM + wc * 32 + 8 * fq;
#pragma unroll
        for (int ai = 0; ai < 2; ++ai)
#pragma unroll
            for (int m = 0; m < 4; ++m) { const int rl = ai * HALF + wr * 64 + m * 16 + fr;
                if (rl < u.rows) { const int en = idx[u.e * ECAP + u.mt * 256 + rl]; bf16_t* rowp = Y + (size_t)((en & 1) * T_ + (en >> 1)) * D_ + col0;
#pragma unroll
                    for (int bj = 0; bj < 2; ++bj) { const f32x4 v0 = acc[ai][bj][m][0], v1 = acc[ai][bj][m][1];
                        u32x4 w; w.x = cvt_pk_bf16(v0[0], v0[1]); w.y = cvt_pk_bf16(v0[2], v0[3]); w.z = cvt_pk_bf16(v1[0], v1[1]); w.w = cvt_pk_bf16(v1[2], v1[3]);
                        *(u32x4*)(rowp + bj * HALF) = w; } } }
    }
};

typedef int v8i __attribute__((ext_vector_type(8)));
template <class Epi, class Sched, bool FP8 = false>
__device__ __forceinline__ void gemm_phase(LAS unsigned char* lds, const bf16_t* A, const bf16_t* Bt, const int K, const Sched& S, const Epi& E, const int sclW = 127, const int sclA = 127) {
    int tid = threadIdx.x; asm volatile("" : "+v"(tid)); const int wid = __builtin_amdgcn_readfirstlane(tid >> 6), lane = tid & 63, wr = wid >> 2, wc = wid & 3, fr = lane & 15, fq = lane >> 4;
    const int nt = K / BK;
    int R0, C0, R1, C1; stage_rc(tid * 16, R0, C0); stage_rc(tid * 16 + 8192, R1, C1);
    unsigned voffB[2];
    { const int Rb0 = Epi::PERM ? ((R0 & ~31) + perm32(R0 & 31)) : R0, Rb1 = Epi::PERM ? ((R1 & ~31) + perm32(R1 & 31)) : R1;
      voffB[0] = (unsigned)(Rb0 * K + C0) * 2u; voffB[1] = (unsigned)(Rb1 * K + C1) * 2u; }
    const size_t kstep = (size_t)(BK * 2);
    const size_t hstep = (size_t)HALF * K * 2;
    const size_t tstep = 2 * hstep;
    const unsigned ldsw = (unsigned)wid * 1024u;
    const int aoff = lds_byte(wr * 64 + fr, fq * 8), boff = lds_byte(wc * 32 + fr, fq * 8);
    const int aoff1 = aoff + 1024, boff1 = boff + 1024;
    const char* Ab = (const char*)A;
#define PG8_SA(b, h) (((b) * 2 + (h)) * HTB)
#define PG8_SB(b, h) ((4 + (b) * 2 + (h)) * HTB)
#define PG8_STAGE(bufoff, gbase, voff) do { _Pragma("unroll") for (int _i = 0; _i < 2; ++_i) \
        __builtin_amdgcn_global_load_lds((const unsigned*)((const char*)(gbase) + (voff)[_i]), (LAS unsigned*)(lds + (bufoff) + ldsw + _i * 8192), 16, 0, 0); } while (0)
#define PG8_STAGE_A(bufoff, kptr, o0, o1) do { \
        __builtin_amdgcn_global_load_lds((const unsigned*)((kptr) + (o0)), (LAS unsigned*)(lds + (bufoff) + ldsw), 16, 0, 0); \
        __builtin_amdgcn_global_load_lds((const unsigned*)((kptr) + (o1)), (LAS unsigned*)(lds + (bufoff) + ldsw + 8192), 16, 0, 0); } while (0)
#define PG8_LDA(dst, b, h) do { _Pragma("unroll") for (int m = 0; m < 4; ++m) _Pragma("unroll") for (int k = 0; k < 2; ++k) dst[m][k] = *(const LAS bf16x8*)(lds + PG8_SA(b, h) + (k ? aoff1 : aoff) + m * 2048); } while (0)
#define PG8_LDB(dst, b, h) do { _Pragma("unroll") for (int n = 0; n < 2; ++n) _Pragma("unroll") for (int k = 0; k < 2; ++k) dst[n][k] = *(const LAS bf16x8*)(lds + PG8_SB(b, h) + (k ? boff1 : boff) + n * 2048); } while (0)
#define PG8_CAT(x0, x1) (__builtin_shufflevector(__builtin_bit_cast(u32x4, x0), __builtin_bit_cast(u32x4, x1), 0, 1, 2, 3, 4, 5, 6, 7))
#define PG8_MMA(ai, bj, At, Bt_) do { __builtin_amdgcn_s_setprio(1); _Pragma("unroll") for (int m = 0; m < 4; ++m) _Pragma("unroll") for (int n = 0; n < 2; ++n) { \
        if constexpr (FP8) { const v8i b8_ = __builtin_bit_cast(v8i, PG8_CAT(Bt_[n][0], Bt_[n][1])), a8_ = __builtin_bit_cast(v8i, PG8_CAT(At[m][0], At[m][1])); \
            asm volatile("v_mfma_scale_f32_16x16x128_f8f6f4 %0, %1, %2, %0, %3, %4 op_sel_hi:[0,0,0]" : "+v"(acc[ai][bj][m][n]) : "v"(b8_), "v"(a8_), "v"(vsclW), "v"(vsclA)); } \
        else { _Pragma("unroll") for (int k = 0; k < 2; ++k) acc[ai][bj][m][n] = __builtin_amdgcn_mfma_f32_16x16x32_bf16(Bt_[n][k], At[m][k], acc[ai][bj][m][n], 0, 0, 0); } } \
        __builtin_amdgcn_s_setprio(0); } while (0)
#define PG8_WAIT_V(n) asm volatile("s_waitcnt vmcnt(" #n ")" ::: "memory")
#define PG8_WAIT_L(n) asm volatile("s_waitcnt lgkmcnt(" #n ")" ::: "memory")
#define PG8_BAR __builtin_amdgcn_s_barrier()
#define PG8_SCHED __builtin_amdgcn_sched_barrier(0)
#define PG8_OFFS(u_, o00, o01, o10, o11) do { const unsigned rb_ = (unsigned)K * 2u; \
        o00 = (unsigned)S.arow(u_, R0) * rb_ + (unsigned)C0 * 2u; o01 = (unsigned)S.arow(u_, R1) * rb_ + (unsigned)C1 * 2u; \
        o10 = (unsigned)S.arow(u_, HALF + R0) * rb_ + (unsigned)C0 * 2u; o11 = (unsigned)S.arow(u_, HALF + R1) * rb_ + (unsigned)C1 * 2u; } while (0)
    Unit cur, nxt; int ui = 0;
    if (!S.next(0, cur)) return;
    f32x4 acc[2][2][4][2];
#pragma unroll
    for (int a = 0; a < 2; ++a)
#pragma unroll
        for (int b = 0; b < 2; ++b)
#pragma unroll
            for (int m = 0; m < 4; ++m)
#pragma unroll
                for (int n = 0; n < 2; ++n) acc[a][b][m][n] = (f32x4){0.f, 0.f, 0.f, 0.f};
    bf16x8 At[4][2], B0[2][2], B1[2][2];
    int vsclW = sclW, vsclA = sclA; asm volatile("" : "+v"(vsclW), "+v"(vsclA));
    unsigned oC00, oC01, oC10, oC11, oN00, oN01, oN10, oN11;
    PG8_OFFS(cur, oC00, oC01, oC10, oC11);
    const char* cB = (const char*)Bt + (size_t)cur.pn * tstep;
    PG8_STAGE(PG8_SB(0, 0), cB, voffB); PG8_STAGE(PG8_SB(0, 1), cB + hstep, voffB); PG8_STAGE_A(PG8_SA(0, 0), Ab, oC00, oC01); PG8_STAGE_A(PG8_SA(0, 1), Ab, oC10, oC11);
    if (wr == 1) PG8_BAR;
    PG8_WAIT_V(2); PG8_BAR;
    PG8_STAGE(PG8_SB(1, 0), cB + kstep, voffB); PG8_STAGE_A(PG8_SA(1, 0), Ab + kstep, oC00, oC01); PG8_STAGE(PG8_SB(1, 1), cB + hstep + kstep, voffB);
    PG8_WAIT_V(6); PG8_BAR;
    for (;;) {
        const bool has_next = S.next(ui + 1, nxt);
        const char* nB = has_next ? (const char*)Bt + (size_t)nxt.pn * tstep : cB;
        if (has_next) { PG8_OFFS(nxt, oN00, oN01, oN10, oN11); } else { oN00 = oC00; oN01 = oC01; oN10 = oC10; oN11 = oC11; }
        for (int t = 0; t < nt; t += 2) {
            const bool last = (t == nt - 2);
            const char* a1 = Ab + (size_t)(t + 1) * kstep;
            const char* a2 = last ? Ab : Ab + (size_t)(t + 2) * kstep; const char* b2 = last ? nB : cB + (size_t)(t + 2) * kstep;
            const char* a3 = a2 + kstep; const char* b3 = b2 + kstep;
            const unsigned x00 = last ? oN00 : oC00, x01 = last ? oN01 : oC01, x10 = last ? oN10 : oC10, x11 = last ? oN11 : oC11;
            PG8_LDB(B0, 0, 0); PG8_LDB(B1, 0, 1); PG8_SCHED; PG8_LDA(At, 0, 0); PG8_STAGE_A(PG8_SA(1, 1), a1, oC10, oC11);
            PG8_WAIT_V(8); PG8_WAIT_L(0); PG8_BAR; PG8_MMA(0, 0, At, B0); PG8_MMA(0, 1, At, B1); PG8_BAR; PG8_SCHED;
            PG8_LDA(At, 0, 1); PG8_STAGE(PG8_SB(0, 0), b2, voffB); PG8_STAGE(PG8_SB(0, 1), b2 + hstep, voffB); PG8_STAGE_A(PG8_SA(0, 0), a2, x00, x01);
            PG8_WAIT_V(8); PG8_WAIT_L(0); PG8_BAR; PG8_MMA(1, 0, At, B0); PG8_MMA(1, 1, At, B1); PG8_BAR; PG8_SCHED;
            PG8_LDB(B0, 1, 0); PG8_LDB(B1, 1, 1); PG8_SCHED; PG8_LDA(At, 1, 0); PG8_STAGE_A(PG8_SA(0, 1), a2, x10, x11);
            PG8_WAIT_V(8); PG8_WAIT_L(0); PG8_BAR; PG8_MMA(0, 0, At, B0); PG8_MMA(0, 1, At, B1); PG8_BAR; PG8_SCHED;
            PG8_LDA(At, 1, 1); PG8_STAGE(PG8_SB(1, 0), b3, voffB); PG8_STAGE(PG8_SB(1, 1), b3 + hstep, voffB); PG8_STAGE_A(PG8_SA(1, 0), a3, x00, x01);
            PG8_WAIT_V(8); PG8_WAIT_L(0); PG8_BAR; PG8_MMA(1, 0, At, B0); PG8_MMA(1, 1, At, B1); PG8_BAR; PG8_SCHED;
        }
        if (wr == 0) PG8_BAR;
        if constexpr (FP8) asm volatile("s_nop 15\n\ts_nop 15" ::: "memory");
        E(acc, cur, wr, wc, fr, fq);
        if (!has_next) break;
#pragma unroll
        for (int a = 0; a < 2; ++a)
#pragma unroll
            for (int b = 0; b < 2; ++b)
#pragma unroll
                for (int m = 0; m < 4; ++m)
#pragma unroll
                    for (int n = 0; n < 2; ++n) acc[a][b][m][n] = (f32x4){0.f, 0.f, 0.f, 0.f};
        cur = nxt; cB = nB; oC00 = oN00; oC01 = oN01; oC10 = oN10; oC11 = oN11; ++ui;
        if (wr == 1) PG8_BAR;
    }
    PG8_WAIT_V(0);
    PG8_BAR;
#undef PG8_SA
#undef PG8_SB
#undef PG8_STAGE
#undef PG8_STAGE_A
#undef PG8_LDA
#undef PG8_LDB
#undef PG8_MMA
#undef PG8_CAT
#undef PG8_WAIT_V
#undef PG8_WAIT_L
#undef PG8_BAR
#undef PG8_SCHED
#undef PG8_OFFS
}

constexpr size_t MiB = 1u << 20;
constexpr size_t WS_CTL = 0, CTL_ZERO_BYTES = 1 * MiB;
constexpr int CW_CNT = 1024;
constexpr int CW_BAR = 4096;
constexpr size_t WS_IDX = 1 * MiB;
constexpr size_t WS_GATE = WS_IDX + 512 * 1024;
constexpr size_t WS_ZS = 2 * MiB;
constexpr size_t WS_WIN = 3 * MiB;
constexpr size_t WS_WOUT0 = WS_WIN + (size_t)3584 * 1024 * 2;
constexpr size_t WS_WGU = WS_WOUT0 + (size_t)1024 * 1024 * 2;
constexpr size_t WS_WDN = WS_WGU + (size_t)5632 * 1024 * 2;
constexpr size_t WS_WQKV = WS_WDN + (size_t)1024 * 2816 * 2;
constexpr size_t WS_WOUT1 = WS_WQKV + (size_t)3072 * 1024 * 2;
constexpr size_t WS_W1E = WS_WOUT1 + (size_t)1024 * 1024 * 2;
constexpr size_t WS_W2E = WS_W1E + (size_t)8 * 7168 * 1024 * 2;
constexpr size_t WS_WEND = WS_W2E + (size_t)8 * 1024 * 3584 * 2;
constexpr size_t WS_HN = (WS_WEND + MiB - 1) / MiB * MiB;
constexpr size_t WS_MIXB = WS_HN + 32 * MiB;
constexpr size_t WS_HA = WS_MIXB + 32 * MiB;
constexpr size_t WS_FNEG = WS_HA + 64 * MiB;
constexpr size_t WS_KMEAN = WS_FNEG + 512 * 1024;
constexpr size_t WS_ROPE = WS_KMEAN + 256 * 1024;
constexpr size_t WS_ZB = WS_ROPE + 3 * MiB - 512 * 1024;
constexpr size_t WS_GDN = WS_ZB + 120 * MiB;
constexpr size_t WS_YBUF = WS_ZB + 256 * MiB;
constexpr size_t WS_FASTEND = WS_ZB + 320 * MiB;

constexpr int RING_BYTES = 131072, LDS_BYTES = 147456, MISC_OFF = LDS_BYTES - 256;

struct Args { const float* in[23]; float* out; unsigned char* ws; int ph_lo, ph_hi; };

__device__ __forceinline__ void transpose_item(const float* W, int ldw, int K, int srccol0, bf16_t* WT, int dstrow0, int k0, LAS float* scr, int lane) {
    { float tv[32]; const float* wp = W + (size_t)(k0 + (lane >> 5)) * ldw + srccol0 + (lane & 31);
#pragma unroll
      for (int i = 0; i < 32; ++i) tv[i] = wp[(size_t)(2 * i) * ldw];
#pragma unroll
      for (int i = 0; i < 32; ++i) scr[(2 * i + (lane >> 5)) * 33 + (lane & 31)] = tv[i]; }
    asm volatile("s_waitcnt lgkmcnt(0)" ::: "memory");
    const int c = lane & 7;
#pragma unroll
    for (int j = 0; j < 4; ++j) { const int n = (lane >> 3) + 8 * j; const LAS float* s = scr + (8 * c) * 33 + n;
        u32x4 o; o.x = cvt_pk_bf16(s[0 * 33], s[1 * 33]); o.y = cvt_pk_bf16(s[2 * 33], s[3 * 33]); o.z = cvt_pk_bf16(s[4 * 33], s[5 * 33]); o.w = cvt_pk_bf16(s[6 * 33], s[7 * 33]);
        *(u32x4*)(WT + (size_t)(dstrow0 + n) * K + k0 + 8 * c) = o; }
    asm volatile("s_waitcnt lgkmcnt(0)" ::: "memory");
}
__device__ __forceinline__ void transpose_item8(const float* W, int ldw, int K, int srccol0, unsigned char* WT, int dstrow0, int k0, LAS float* scr, int lane, float wscale) {
    { float tv[64]; const float* wp = W + (size_t)(k0 + (lane >> 5)) * ldw + srccol0 + (lane & 31);
#pragma unroll
      for (int i = 0; i < 64; ++i) tv[i] = wp[(size_t)(2 * i) * ldw];
#pragma unroll
      for (int i = 0; i < 64; ++i) scr[(2 * i + (lane >> 5)) * 33 + (lane & 31)] = tv[i]; }
    asm volatile("s_waitcnt lgkmcnt(0)" ::: "memory");
    const int n = lane >> 1, hf = lane & 1; const LAS float* s = scr + (64 * hf) * 33 + n;
    unsigned char* d = WT + (size_t)(dstrow0 + n) * K + k0 + 64 * hf;
#pragma unroll
    for (int q = 0; q < 4; ++q) { u32x4 o;
        o.x = pk4_fp8(s[(16 * q + 0) * 33] * wscale, s[(16 * q + 1) * 33] * wscale, s[(16 * q + 2) * 33] * wscale, s[(16 * q + 3) * 33] * wscale);
        o.y = pk4_fp8(s[(16 * q + 4) * 33] * wscale, s[(16 * q + 5) * 33] * wscale, s[(16 * q + 6) * 33] * wscale, s[(16 * q + 7) * 33] * wscale);
        o.z = pk4_fp8(s[(16 * q + 8) * 33] * wscale, s[(16 * q + 9) * 33] * wscale, s[(16 * q + 10) * 33] * wscale, s[(16 * q + 11) * 33] * wscale);
        o.w = pk4_fp8(s[(16 * q + 12) * 33] * wscale, s[(16 * q + 13) * 33] * wscale, s[(16 * q + 14) * 33] * wscale, s[(16 * q + 15) * 33] * wscale);
        *(u32x4*)(d + 16 * q) = o; }
    asm volatile("s_waitcnt lgkmcnt(0)" ::: "memory");
}
struct TwItem { const float* src; unsigned char* dst; int ldw, dp; };
template <bool FP8> __device__ __forceinline__ void tw_load(f32x4 (&v)[16], const TwItem& t) {
    constexpr int RW = FP8 ? 16 : 8;
#pragma unroll
    for (int i = 0; i < RW; ++i) v[i] = *(const f32x4*)(t.src + (size_t)i * t.ldw);
}
template <bool FP8> __device__ __forceinline__ void tw_store(const f32x4 (&v)[16], const TwItem& t, LAS unsigned char* buf, int tid, int lane, int wave, float ws_) {
#pragma unroll
    for (int c = 0; c < 4; ++c) { u32x4 o;
        if (FP8) { o.x = pk4_fp8(v[0][c] * ws_, v[1][c] * ws_, v[2][c] * ws_, v[3][c] * ws_); o.y = pk4_fp8(v[4][c] * ws_, v[5][c] * ws_, v[6][c] * ws_, v[7][c] * ws_);
                   o.z = pk4_fp8(v[8][c] * ws_, v[9][c] * ws_, v[10][c] * ws_, v[11][c] * ws_); o.w = pk4_fp8(v[12][c] * ws_, v[13][c] * ws_, v[14][c] * ws_, v[15][c] * ws_); }
        else { o.x = cvt_pk_bf16(v[0][c], v[1][c]); o.y = cvt_pk_bf16(v[2][c], v[3][c]); o.z = cvt_pk_bf16(v[4][c], v[5][c]); o.w = cvt_pk_bf16(v[6][c], v[7][c]); }
        *(LAS u32x4*)(buf + (4 * lane + c) * 144 + 16 * wave) = o; }
    asm volatile("s_waitcnt lgkmcnt(0)\n\ts_barrier" ::: "memory");
#pragma unroll
    for (int q = 0; q < 4; ++q) { const int ix = tid + 512 * q, n = ix >> 3, sg = ix & 7; const u32x4 o = *(const LAS u32x4*)(buf + n * 144 + 16 * sg); *(u32x4*)(t.dst + (size_t)n * t.dp + 16 * sg) = o; }
}
#define TW_LOOP(FP8_, FIRST_, END_, STRIDE_, DECODE_, SCALE_) do { \
    f32x4 va_[16], vb_[16]; TwItem ta_, tb_; int it_ = (FIRST_); \
    asm volatile("s_waitcnt lgkmcnt(0)\n\ts_barrier" ::: "memory");     \
    if (it_ < (END_)) { ta_ = DECODE_(it_); tw_load<FP8_>(va_, ta_); int last_ = 0; \
        while (true) {     \
            if (!(it_ + (STRIDE_) < (END_))) { last_ = 0; break; } \
            it_ += (STRIDE_); tb_ = DECODE_(it_); tw_load<FP8_>(vb_, tb_); tw_store<FP8_>(va_, ta_, lds, tid, lane, wave, SCALE_); \
            if (!(it_ + (STRIDE_) < (END_))) { last_ = 1; break; } \
            it_ += (STRIDE_); ta_ = DECODE_(it_); tw_load<FP8_>(va_, ta_); tw_store<FP8_>(vb_, tb_, lds + 36864, tid, lane, wave, SCALE_); } \
        if (last_ == 0) tw_store<FP8_>(va_, ta_, lds, tid, lane, wave, SCALE_); else tw_store<FP8_>(vb_, tb_, lds + 36864, tid, lane, wave, SCALE_); } } while (0)
__device__ __forceinline__ int map_inproj(int n) { const int g = n >> 9, r = n & 511; const int off = g == 0 ? 0 : g == 1 ? 512 : g == 2 ? 1024 : g == 3 ? 1540 : g == 4 ? 2052 : g == 5 ? 2564 : 3084; return off + r; }
__device__ __forceinline__ int map_qkv(int n) { if (n >= 2048) return n; const int t = n >> 8, r = n & 255, half = r >> 7, w = r & 127; return t * 256 + (w >> 6) * 128 + (w & 63) + 64 * half; }
__device__ __forceinline__ int map_gu(int n, int F) { const int j = n >> 8, r = n & 255; return r < 128 ? j * 128 + r : F + j * 128 + (r - 128); }

__device__ __forceinline__ TwItem tw_expert(int I, const float* w_e1, const float* w_e2, unsigned char* W1, unsigned char* W2, int lane, int wave) {
    TwItem t; int r = I; constexpr int J1 = 8 * 28, J2 = 28 * 4;
    if (r < 8 * J1) { const int e = r / J1, q = r % J1, kb = q / 28, j = q % 28;
        t.src = w_e1 + (size_t)e * 1024 * 7168 + (size_t)(128 * kb + 16 * wave) * 7168 + map_gu(256 * j + 4 * lane, 3584); t.ldw = 7168;
        t.dst = W1 + (size_t)e * 7168 * 1024 + (size_t)(256 * j) * 1024 + 128 * kb; t.dp = 1024; }
    else { r -= 8 * J1; const int e = r / J2, q = r % J2, kb = q >> 2, j = q & 3;
        t.src = w_e2 + (size_t)e * 3584 * 1024 + (size_t)(128 * kb + 16 * wave) * 1024 + 256 * j + 4 * lane; t.ldw = 1024;
        t.dst = W2 + (size_t)e * 1024 * 3584 + (size_t)(256 * j) * 3584 + 128 * kb; t.dp = 3584; }
    return t;
}
__device__ __forceinline__ void rms_row(const float* xrow, const float* gain, bf16_t* orow, int lane, f32x4 (&v)[4]) {
    const f32x4* xr = (const f32x4*)xrow + lane; const f32x4* gr = (const f32x4*)gain + lane;
    float s = 0.f;
#pragma unroll
    for (int j = 0; j < 4; ++j) { v[j] = xr[64 * j]; s += (v[j].x * v[j].x + v[j].y * v[j].y) + (v[j].z * v[j].z + v[j].w * v[j].w); }
    const float r = rsqrtf(wave_sum(s) * (1.f / 1024.f) + 1e-6f);
    u32x2* o8 = (u32x2*)orow + lane;
#pragma unroll
    for (int j = 0; j < 4; ++j) { const f32x4 g = gr[64 * j]; v[j] = v[j] * r * g; u32x2 w; w.x = cvt_pk_bf16(v[j].x, v[j].y); w.y = cvt_pk_bf16(v[j].z, v[j].w); o8[64 * j] = w; }
}

template <int NR, bool FP8, bool IN_BF16 = false> __device__ __forceinline__ void rms_rows(const void* x, const float* gain, void* out, int m0, int mstep, int lane, f32x4 (&v)[NR][4]) {
#pragma unroll
    for (int r = 0; r < NR; ++r) {
        if (IN_BF16) { const u32x2* xr = (const u32x2*)((const bf16_t*)x + (size_t)(m0 + r * mstep) * D_) + lane; u32x2 t[4];
#pragma unroll
            for (int j = 0; j < 4; ++j) t[j] = xr[64 * j];
#pragma unroll
            for (int j = 0; j < 4; ++j) { v[r][j].x = __uint_as_float(t[j].x << 16); v[r][j].y = __uint_as_float(t[j].x & 0xffff0000u); v[r][j].z = __uint_as_float(t[j].y << 16); v[r][j].w = __uint_as_float(t[j].y & 0xffff0000u); } }
        else { const f32x4* xr = (const f32x4*)((const float*)x + (size_t)(m0 + r * mstep) * D_) + lane;
#pragma unroll
            for (int j = 0; j < 4; ++j) v[r][j] = xr[64 * j]; } }
    f32x4 g[4]; { const f32x4* gr = (const f32x4*)gain + lane;
#pragma unroll
        for (int j = 0; j < 4; ++j) g[j] = gr[64 * j]; }
#pragma unroll
    for (int r = 0; r < NR; ++r) { float s = 0.f;
#pragma unroll
        for (int j = 0; j < 4; ++j) s += (v[r][j].x * v[r][j].x + v[r][j].y * v[r][j].y) + (v[r][j].z * v[r][j].z + v[r][j].w * v[r][j].w);
        const float rs = rsqrtf(wave_sum(s) * (1.f / 1024.f) + 1e-6f);
        const size_t m = (size_t)(m0 + r * mstep);
#pragma unroll
        for (int j = 0; j < 4; ++j) { v[r][j] = v[r][j] * rs * g[j];
            if (FP8) ((unsigned*)((unsigned char*)out + m * D_) + lane)[64 * j] = pk4_fp8(v[r][j].x, v[r][j].y, v[r][j].z, v[r][j].w);
            else { u32x2 w; w.x = cvt_pk_bf16(v[r][j].x, v[r][j].y); w.y = cvt_pk_bf16(v[r][j].z, v[r][j].w); ((u32x2*)((bf16_t*)out + m * D_) + lane)[64 * j] = w; } } }
}
#define XB_TMO      128
#define XB_XCNT(j)  (256  + 64 * (j))
#define XB_XSUB(j)  (1280 + 64 * (j))
#define XB_XGEN(j)  (2304 + 64 * (j))
#define XB_TOP      3328
#define XB_TOPGEN   3392
#define XCD_BAR_WORDS 3456
#define XB_SPIN_CAP (1u << 18)

__device__ __forceinline__ unsigned xb_ld(unsigned* p)              { return __hip_atomic_load(p, __ATOMIC_RELAXED, __HIP_MEMORY_SCOPE_AGENT); }
__device__ __forceinline__ unsigned xb_add(unsigned* p, unsigned v) { return __hip_atomic_fetch_add(p, v, __ATOMIC_RELAXED, __HIP_MEMORY_SCOPE_AGENT); }
__device__ __forceinline__ unsigned xb_xcc_id() { return (unsigned)__builtin_amdgcn_s_getreg((3 << 11) | 20) & 0xFu; }
#define XB_SPIN(cond, bar) do { unsigned _sp = 0; while (cond) { __builtin_amdgcn_s_sleep(1); \
    if ((++_sp & 255u) == 0u) { if (xb_ld(&(bar)[XB_TMO])) break; if (_sp > XB_SPIN_CAP) { atomicAdd(&(bar)[XB_TMO], 1u); break; } } } } while (0)

struct XcdBarrier {
    unsigned* bar; unsigned x;
    volatile LAS unsigned* st;
};

__device__ __forceinline__ XcdBarrier xcd_barrier_post(unsigned* bar, volatile LAS unsigned* st) {
    XcdBarrier b; b.bar = bar; b.x = xb_xcc_id(); b.st = st;
    if (threadIdx.x == 0) (void)xb_add(&bar[XB_XCNT(b.x)], 1u);
    return b;
}
__device__ __forceinline__ void xcd_barrier_complete(unsigned* bar, unsigned x, unsigned& nloc, unsigned& nx) {
    const unsigned G = gridDim.x * gridDim.y * gridDim.z;
    unsigned sum, cnt, mine, sp = 0u;
    for (;;) {
        sum = 0u; cnt = 0u; mine = 0u;
#pragma unroll
        for (unsigned j = 0; j < 16; ++j) { const unsigned c = xb_ld(&bar[XB_XCNT(j)]); sum += c; cnt += (c > 0u) ? 1u : 0u; mine = (j == x) ? c : mine; }
        if (sum == G) break;
        __builtin_amdgcn_s_sleep(1);
        if ((++sp & 255u) == 0u) { if (xb_ld(&bar[XB_TMO])) break; if (sp > XB_SPIN_CAP) { atomicAdd(&bar[XB_TMO], 1u); break; } }
    }
    nloc = mine > 0u ? mine : 1u; nx = cnt > 0u ? cnt : 1u;
}

__device__ __forceinline__ void xcd_barrier(const XcdBarrier& b) {
    asm volatile("s_waitcnt vmcnt(0)" ::: "memory");
    __syncthreads();
    if (threadIdx.x == 0) {
        unsigned* bar = b.bar;
        __builtin_amdgcn_s_waitcnt(0);
        unsigned nloc = b.st[0], nx = b.st[1];
        if (nloc == 0u) { xcd_barrier_complete(bar, b.x, nloc, nx); b.st[0] = nloc; b.st[1] = nx; }
        const unsigned old = xb_add(&bar[XB_XSUB(b.x)], 1u);
        const unsigned gen = old / nloc;
        if (old + 1u == (gen + 1u) * nloc) {
            __builtin_amdgcn_fence(__ATOMIC_RELEASE, "agent");
            asm volatile("s_waitcnt vmcnt(0)" ::: "memory");
            const unsigned og = xb_add(&bar[XB_TOP], 1u);
            const unsigned tg = og / nx;
            if (og + 1u == (tg + 1u) * nx) xb_add(&bar[XB_TOPGEN], 1u);
            else XB_SPIN(xb_ld(&bar[XB_TOPGEN]) == tg, bar);
            __builtin_amdgcn_fence(__ATOMIC_ACQUIRE, "agent");
            xb_add(&bar[XB_XGEN(b.x)], 1u);
            asm volatile("s_waitcnt vmcnt(0)" ::: "memory");
        } else {
            XB_SPIN(xb_ld(&bar[XB_XGEN(b.x)]) == gen, bar);
            __builtin_amdgcn_fence(__ATOMIC_ACQUIRE, "agent");
            asm volatile("s_waitcnt vmcnt(0)" ::: "memory");
        }
    }
    __syncthreads();
}


__device__ __forceinline__ void rms_row8(const float* xrow, const float* gain, unsigned char* orow, int lane, f32x4 (&v)[4]) {
    const f32x4* xr = (const f32x4*)xrow + lane; const f32x4* gr = (const f32x4*)gain + lane;
    float s = 0.f;
#pragma unroll
    for (int j = 0; j < 4; ++j) { v[j] = xr[64 * j]; s += (v[j].x * v[j].x + v[j].y * v[j].y) + (v[j].z * v[j].z + v[j].w * v[j].w); }
    const float r = rsqrtf(wave_sum(s) * (1.f / 1024.f) + 1e-6f);
    unsigned* o4 = (unsigned*)orow + lane;
#pragma unroll
    for (int j = 0; j < 4; ++j) { const f32x4 g = gr[64 * j]; v[j] = v[j] * r * g; o4[64 * j] = pk4_fp8(v[j].x, v[j].y, v[j].z, v[j].w); }
}
 constexpr int TAIL_A = 4, TAIL_B = 4;
 constexpr int GU_R = 6;
__host__ __device__ constexpr int tail_rounds(int n) { return TAIL_A + TAIL_B * n / 4; }
__host__ __device__ constexpr int tail_prev(int n) { int p = 0; for (int i = 0; i < n; ++i) p += tail_rounds(i); return p; }
constexpr int N_EXPERT_ITEMS = 8 * 8 * 224 + 8 * 28 * 32, NT_TAIL = 8 * 16 * tail_prev(12);
static_assert(NT_TAIL / 8 + 128 * GU_R <= N_EXPERT_ITEMS / 8, "expert items over-assigned");
enum Phase { PH_PRO = 0, PH_INPROJ = 1, PH_FOXPREP = 2, PH_ATTN0 = 3, PH_GDN3 = 4, PH_OUT0 = 5, PH_NORM2 = 6, PH_GU = 7, PH_DN = 8, PH_NORM3 = 9, PH_QKV = 10, PH_MOBAPREP = 11, PH_ATTN1 = 12, PH_OUT1 = 13, PH_ROUTE = 14, PH_MOE1 = 15, PH_MOE2 = 16, PH_COMB = 17, PH_END = 18 };

__device__ __forceinline__ unsigned long long karg64(int byte_off) { unsigned long long v; const unsigned long long kp = (unsigned long long)__builtin_amdgcn_kernarg_segment_ptr();
    asm volatile("s_load_dwordx2 %0, %1, %2\n\ts_waitcnt lgkmcnt(0)" : "=s"(v) : "s"(kp), "s"(byte_off)); return v; }
#define ARG_IN(i) ((const float*)(const GAS float*)karg64(8 * (i)))
#define ARG_OUT ((float*)(GAS float*)karg64(184))
 constexpr int KN[4] = {1,1,1,1};
 constexpr int REPS[20] = {1,1,1,1,1,1,1,1,1,1,1,1,1,1,1,1,1,1,1,1};
__global__ void __launch_bounds__(512, 2) mk_fwd(Args args) {
    extern __shared__ __attribute__((aligned(16))) unsigned char lds_raw[];
    LAS unsigned char* lds = (LAS unsigned char*)lds_raw;
    const int G = gridDim.x, bx = blockIdx.x, NGW = G * NWAVES;
#define PH_IDS() int tid = threadIdx.x; asm volatile("" : "+v"(tid)); const int lane = tid & 63, wave = __builtin_amdgcn_readfirstlane(tid >> 6); const int gw = bx * NWAVES + wave; (void)lane; (void)gw
#define ws (args.ws)
#define ctl ((unsigned*)(ws + WS_CTL))
#define cnt ((int*)(ctl + CW_CNT))
#define idx ((int*)(ws + WS_IDX))
#define gate ((float*)(ws + WS_GATE))
#define zs ((float*)(ws + WS_ZS))
#define Win ((bf16_t*)(ws + WS_WIN))
#define Wout0 ((bf16_t*)(ws + WS_WOUT0))
#define Wgu ((bf16_t*)(ws + WS_WGU))
#define Wdn ((bf16_t*)(ws + WS_WDN))
#define Wqkv ((bf16_t*)(ws + WS_WQKV))
#define Wout1 ((bf16_t*)(ws + WS_WOUT1))
#define W1e ((bf16_t*)(ws + WS_W1E))
#define W2e ((bf16_t*)(ws + WS_W2E))
#define hn ((bf16_t*)(ws + WS_HN))
#define mixb ((bf16_t*)(ws + WS_MIXB))
#define hA ((bf16_t*)(ws + WS_HA))
#define hB ((bf16_t*)(ws + WS_HA + 32 * MiB))
#define zb ((bf16_t*)(ws + WS_ZB))
#define ybuf ((bf16_t*)(ws + WS_YBUF))
#define fneg ((float*)(ws + WS_FNEG))
#define kmean ((float*)(ws + WS_KMEAN))
#define ropec ((float*)(ws + WS_ROPE))
#define ropes (ropec + 4096 * 64)
#define GBUFS() gd::GdnBufs gbufs; gbufs.T = (bf16_t*)(ws + WS_GDN); gbufs.RT = (float*)(ws + WS_GDN + 32 * MiB); gbufs.ST = (bf16_t*)(ws + WS_GDN + 96 * MiB); gbufs.QT = (bf16_t*)(ws + WS_GDN + 128 * MiB); gbufs.OL = (float*)(ws + WS_GDN + 144 * MiB)
    const int lo = args.ph_lo, hi = args.ph_hi;
#define IN(k) (lo <= (k) && (k) < hi)
    volatile LAS unsigned* MISC = (volatile LAS unsigned*)(lds + MISC_OFF);
    if (threadIdx.x < 64) MISC[threadIdx.x] = 0u;
    __syncthreads();
    XcdBarrier bar; bar.bar = ctl + CW_BAR; bar.x = 0; bar.st = MISC + 8;
    if (hi - lo > 1) bar = xcd_barrier_post(ctl + CW_BAR, MISC + 8);
#define SEAM(k) do { if (IN(k) && IN((k) + 1)) xcd_barrier(bar); } while (0)

    if (IN(PH_PRO)) for (int rep_ = 0; rep_ < REPS[PH_PRO]; ++rep_) { if (rep_) xcd_barrier(bar); PH_IDS();
        const float* w_in = ARG_IN(2); const float* w_out0 = ARG_IN(10); const float* w_e1 = ARG_IN(21); const float* w_e2 = ARG_IN(22);
        auto dec_d0 = [&](int I) -> TwItem { TwItem t;
            if (I < 224) { const int kb = I / 14, j = I % 14; t.src = w_in + (size_t)(64 * kb + 8 * wave) * 3596 + map_inproj(256 * j + 4 * lane); t.ldw = 3596; t.dst = (unsigned char*)Win + (size_t)(256 * j) * 2048 + 128 * kb; t.dp = 2048; }
            else { const int r = I - 224, kb = r >> 2, j = r & 3; t.src = w_out0 + (size_t)(64 * kb + 8 * wave) * 1024 + 256 * j + 4 * lane; t.ldw = 1024; t.dst = (unsigned char*)Wout0 + (size_t)(256 * j) * 2048 + 128 * kb; t.dp = 2048; }
            return t; };
        auto dec_ex = [&](int I) -> TwItem { return tw_expert(I, w_e1, w_e2, (unsigned char*)W1e, (unsigned char*)W2e, lane, wave); };
        for (int k_ = 0; k_ < KN[0]; ++k_) { TW_LOOP(false, bx, 288, G, dec_d0, 1.f);
        TW_LOOP(true, NT_TAIL / 8 + 128 * GU_R + bx, N_EXPERT_ITEMS / 8, G, dec_ex, 64.f); __syncthreads(); }
        __syncthreads();
        LAS float* wsm = (LAS float*)lds;
        for (int i = tid; i < 3 * 1024; i += 512) { const int k = i & 1023, c = i >> 10; const f32x4 w4 = *(const f32x4*)(w_in + (size_t)k * 3596 + (c == 0 ? 1536 : 3072 + 4 * c));
            wsm[(4 * c + 0) * 1024 + k] = w4.x; wsm[(4 * c + 1) * 1024 + k] = w4.y; wsm[(4 * c + 2) * 1024 + k] = w4.z; wsm[(4 * c + 3) * 1024 + k] = w4.w; }
        __syncthreads();
        const float* x_in = ARG_IN(0); const float* g_in = ARG_IN(1);
        for (int k_ = 0; k_ < KN[1]; ++k_) for (int m = gw; m < T_; m += 8 * NGW) {
            f32x4 v[8][4]; rms_rows<8, false>(x_in, g_in, hn, m, NGW, lane, v);
#pragma unroll
            for (int j = 0; j < 12; ++j) { float a[8];
#pragma unroll
                for (int r = 0; r < 8; ++r) a[r] = 0.f;
#pragma unroll
                for (int q = 0; q < 4; ++q) { const f32x4 w4 = *(const LAS f32x4*)(wsm + j * 1024 + 256 * q + 4 * lane);
#pragma unroll
                    for (int r = 0; r < 8; ++r) a[r] += (v[r][q].x * w4.x + v[r][q].y * w4.y) + (v[r][q].z * w4.z + v[r][q].w * w4.w); }
#pragma unroll
                for (int r = 0; r < 8; ++r) { const float d = wave_sum(a[r]); if (lane == 0) zs[(size_t)(m + r * NGW) * 12 + j] = d; } }
        }
        for (int i = bx * 512 + tid; i < 4096 * 64; i += G * 512) { const int pos = i >> 6, j = i & 63; const float inv = exp2f(-(float)j * (13.287712379549449f / 64.f)); float sn, cs; sincosf((float)pos * inv, &sn, &cs); ropec[i] = cs; ropes[i] = sn; }
        __syncthreads();
    }
    SEAM(PH_PRO);
    if (IN(PH_INPROJ)) for (int rep_ = 0; rep_ < REPS[PH_INPROJ]; ++rep_) { if (rep_) xcd_barrier(bar); DenseOrder S; S.init(T_, 3584, G, bx); EpiBf16 E{zb, 3584}; gemm_phase(lds, hn, Win, 1024, S, E);
        if (bx >= 128 && G == 256 && rep_ == 0) {
            PH_IDS(); __syncthreads();
            const float* w_gu = ARG_IN(12); const float* w_dn = ARG_IN(13); const float* w_qkv = ARG_IN(15); const float* w_out1 = ARG_IN(18);
            auto dec_d1 = [&](int I) -> TwItem { TwItem t;
                if (I < 352) { const int kb = I / 22, j = I % 22; t.src = w_gu + (size_t)(64 * kb + 8 * wave) * 5632 + map_gu(256 * j + 4 * lane, 2816); t.ldw = 5632; t.dst = (unsigned char*)Wgu + (size_t)(256 * j) * 2048 + 128 * kb; t.dp = 2048; }
                else { const int r = I - 352, kb = r >> 2, j = r & 3; t.src = w_out1 + (size_t)(64 * kb + 8 * wave) * 1024 + 256 * j + 4 * lane; t.ldw = 1024; t.dst = (unsigned char*)Wout1 + (size_t)(256 * j) * 2048 + 128 * kb; t.dp = 2048; }
                return t; };
            auto dec_q = [&](int I) -> TwItem { TwItem t;
                if (I < 96) { const int kb = I / 12, j = I % 12; t.src = w_qkv + (size_t)(128 * kb + 16 * wave) * 3072 + map_qkv(256 * j + 4 * lane); t.ldw = 3072; t.dst = (unsigned char*)Wqkv + (size_t)(256 * j) * 1024 + 128 * kb; t.dp = 1024; }
                else { const int r = I - 96, kb = r >> 2, j = r & 3; t.src = w_dn + (size_t)(128 * kb + 16 * wave) * 1024 + 256 * j + 4 * lane; t.ldw = 1024; t.dst = (unsigned char*)Wdn + (size_t)(256 * j) * 2816 + 128 * kb; t.dp = 2816; }
                return t; };
            TW_LOOP(false, (bx < 240 ? bx - 128 : (1 << 30)), 416, 112, dec_d1, 1.f);
            TW_LOOP(true, (bx < 240 ? bx - 128 : (1 << 30)), 184, 112, dec_q, 64.f);
            if (bx >= 240) {
                const int bh = bx - 240, q = wave, b = bh >> 2, h = bh & 3; const float fb = ARG_IN(3)[h]; const float* qg = ARG_IN(4); const float* kg = ARG_IN(5);
                float* fr_ = fneg + (size_t)bh * 4160 + q * 512 + lane * 8; LAS float* tl_ = (LAS float*)(lds + 73728);
                float tot = 0.f, ls_[8];
#pragma unroll
                for (int i = 0; i < 8; ++i) { const float xv = zs[(size_t)(b * 4096 + q * 512 + lane * 8 + i) * 12 + h] + fb; ls_[i] = xv > 0.f ? -log1pf(expf(-xv)) : xv - log1pf(expf(xv)); tot += ls_[i]; }
                float inc = tot;
#pragma unroll
                for (int o = 1; o < 64; o <<= 1) { const float t = __shfl_up(inc, o); if (lane >= o) inc += t; }
                if (lane == 63) tl_[wave] = inc;
                __syncthreads();
                float run = inc - tot; for (int j = 0; j < q; ++j) run += tl_[j];
                f32x4 o0, o1; run += ls_[0]; o0.x = -run * 11.313708498984761f; run += ls_[1]; o0.y = -run * 11.313708498984761f; run += ls_[2]; o0.z = -run * 11.313708498984761f; run += ls_[3]; o0.w = -run * 11.313708498984761f;
                run += ls_[4]; o1.x = -run * 11.313708498984761f; run += ls_[5]; o1.y = -run * 11.313708498984761f; run += ls_[6]; o1.z = -run * 11.313708498984761f; run += ls_[7]; o1.w = -run * 11.313708498984761f;
                *(f32x4*)fr_ = o0; *(f32x4*)(fr_ + 4) = o1;
                if (q == 0) { float mq = fmaxf(fabsf(qg[lane]), fabsf(qg[lane + 64])), mk = fmaxf(fabsf(kg[lane]), fabsf(kg[lane + 64]));
                    for (int o = 32; o >= 1; o >>= 1) { mq = fmaxf(mq, __shfl_xor(mq, o)); mk = fmaxf(mk, __shfl_xor(mk, o)); }
                    if (lane == 0) fneg[(size_t)bh * 4160 + 4096] = (104.f + 2.f * 128.f * 0.08838834764831845f * mq * mk) * 11.313708498984761f; }
            }
            __syncthreads();
        }
    }

    SEAM(PH_INPROJ);
    if (IN(PH_FOXPREP)) { PH_IDS();
        const float* qg = ARG_IN(4); const float* kg = ARG_IN(5);
        const int dcol = (lane & 15) * 8;
        float gq[8], gk[8];
#pragma unroll
        for (int e = 0; e < 8; ++e) { gq[e] = qg[dcol + e]; gk[e] = kg[dcol + e]; }
        for (int m = gw; m < T_; m += NGW) {
#pragma unroll
            for (int part = 0; part < 2; ++part) {
                bf16_t* p = zb + (size_t)m * 3584 + part * 512 + lane * 8;
                const u32x4 raw = *(const u32x4*)p; float x[8];
                x[0] = __uint_as_float(raw.x << 16); x[1] = __uint_as_float(raw.x & 0xffff0000u); x[2] = __uint_as_float(raw.y << 16); x[3] = __uint_as_float(raw.y & 0xffff0000u);
                x[4] = __uint_as_float(raw.z << 16); x[5] = __uint_as_float(raw.z & 0xffff0000u); x[6] = __uint_as_float(raw.w << 16); x[7] = __uint_as_float(raw.w & 0xffff0000u);
                float ss = 0.f;
#pragma unroll
                for (int e = 0; e < 8; ++e) ss += x[e] * x[e];
                ss += __shfl_xor(ss, 1); ss += __shfl_xor(ss, 2); ss += __shfl_xor(ss, 4); ss += __shfl_xor(ss, 8);
                const float r = rsqrtf(ss * (1.f / 128.f) + 1e-6f);
#pragma unroll
                for (int e = 0; e < 8; ++e) x[e] = x[e] * r * (part ? gk[e] : gq[e]);
                u32x4 w; w.x = cvt_pk_bf16(x[0], x[1]); w.y = cvt_pk_bf16(x[2], x[3]); w.z = cvt_pk_bf16(x[4], x[5]); w.w = cvt_pk_bf16(x[6], x[7]);
                *(u32x4*)p = w;
            }
        }
        if (G != 256 && gw < 16) {
            const int b = gw >> 2, h = gw & 3; const float fb = ARG_IN(3)[h];
            float tot = 0.f;
            for (int i = 0; i < 64; ++i) { const float xv = zs[(size_t)(b * 4096 + lane * 64 + i) * 12 + h] + fb; tot += xv > 0.f ? -log1pf(expf(-xv)) : xv - log1pf(expf(xv)); }
            float inc = tot;
#pragma unroll
            for (int o = 1; o < 64; o <<= 1) { const float t = __shfl_up(inc, o); if (lane >= o) inc += t; }
            float run = inc - tot;
            for (int i = 0; i < 64; ++i) { const float xv = zs[(size_t)(b * 4096 + lane * 64 + i) * 12 + h] + fb; run += xv > 0.f ? -log1pf(expf(-xv)) : xv - log1pf(expf(xv)); fneg[(size_t)gw * 4160 + lane * 64 + i] = -run * 11.313708498984761f; }
            { float mq = 0.f, mk = 0.f;
              mq = fmaxf(fabsf(qg[lane]), fabsf(qg[lane + 64])); mk = fmaxf(fabsf(kg[lane]), fabsf(kg[lane + 64]));
              for (int o = 32; o >= 1; o >>= 1) { mq = fmaxf(mq, __shfl_xor(mq, o)); mk = fmaxf(mk, __shfl_xor(mk, o)); }
              if (lane == 0) fneg[(size_t)gw * 4160 + 4096] = (104.f + 2.f * 128.f * 0.08838834764831845f * mq * mk) * 11.313708498984761f; }
        }
    }
    if (IN(PH_FOXPREP)) for (int rep_ = 0; rep_ < REPS[18]; ++rep_) { if (rep_) xcd_barrier(bar); PH_IDS();
        __syncthreads(); GBUFS();
        const float* cw_ = ARG_IN(6); const float* al_ = ARG_IN(7); const float* dt_ = ARG_IN(8);
        for (int ci = bx; ci < 1024; ci += G) gd::gdn_chunk(ci, zb, zs, cw_, al_, dt_, gbufs, (LAS char*)lds);
    }
    SEAM(PH_FOXPREP);
    if (IN(PH_ATTN0)) for (int rep_ = 0; rep_ < REPS[PH_ATTN0]; ++rep_) { if (rep_) xcd_barrier(bar);
        { GBUFS(); for (int rs_ = 0; rs_ < REPS[19]; ++rs_) { if (rs_) xcd_barrier(bar); if (bx < 64) gd::gdn_scan(bx & 15, bx >> 4, gbufs, (LAS char*)lds); } }
        for (int L = bx; L < 256; L += G) { const int bh = L & 15, cur = (L < 64) ? (L >> 4) : 15 - ((L - 64) >> 4), b = bh >> 2, h = bh & 3;
            const bf16_t* base = zb + (size_t)b * 4096 * 3584 + h * 128;
            at::attn_unit<0, 3584, 1024>(base, base + 512, base + 1024, mixb + (size_t)b * 4096 * 1024 + h * 128, fneg + (size_t)bh * 4160, 2 * cur, 2 * cur + 1, (LAS char*)lds); }
        if (bx >= 64 && rep_ == 0) {
            PH_IDS();
            const float* w_e1 = ARG_IN(21); const float* w_e2 = ARG_IN(22);
            const int n_ = (bx - 64) >> 4, rounds_ = tail_rounds(n_), prev_ = tail_prev(n_);
            const int start_ = 16 * prev_ + (bx & 15) * rounds_;
            auto dec_ex = [&](int I) -> TwItem { return tw_expert(I, w_e1, w_e2, (unsigned char*)W1e, (unsigned char*)W2e, lane, wave); };
            TW_LOOP(true, start_, start_ + rounds_, 1, dec_ex, 64.f);
            __syncthreads();
        }
    }
    SEAM(PH_ATTN0);
    if (IN(PH_GDN3)) for (int rep_ = 0; rep_ < REPS[PH_GDN3]; ++rep_) { if (rep_) xcd_barrier(bar); GBUFS(); const float* on_ = ARG_IN(9); for (int ci = bx; ci < 1024; ci += G) gd::gdn_out(ci, gbufs, zb, on_, mixb, (LAS char*)lds); }
    SEAM(PH_GDN3);
    if (IN(PH_OUT0)) for (int rep_ = 0; rep_ < REPS[PH_OUT0]; ++rep_) { if (rep_) xcd_barrier(bar); DenseOrder S; S.init(T_, 1024, G, bx); EpiResB<false> E{hA, ARG_IN(0), 1024}; gemm_phase(lds, mixb, Wout0, 1024, S, E); }
    SEAM(PH_OUT0);
    if (IN(PH_NORM2)) for (int rep_ = 0; rep_ < REPS[PH_NORM2]; ++rep_) { if (rep_) xcd_barrier(bar); PH_IDS(); const float* g_in = ARG_IN(11); for (int m = gw; m < T_; m += 8 * NGW) { f32x4 v[8][4]; rms_rows<8, false, true>(hA, g_in, hn, m, NGW, lane, v); } }
    SEAM(PH_NORM2);
    if (IN(PH_GU)) for (int rep_ = 0; rep_ < REPS[PH_GU]; ++rep_) { if (rep_) xcd_barrier(bar); DenseOrder S; S.init(T_, 5632, G, bx); EpiSwiglu8 E{(unsigned char*)zb, 2816, 4.f}; gemm_phase(lds, hn, Wgu, 1024, S, E);
        if (bx >= 128 && G == 256 && rep_ == 0 && GU_R > 0) { PH_IDS(); __syncthreads();
            const float* w_e1 = ARG_IN(21); const float* w_e2 = ARG_IN(22);
            auto dec_ex = [&](int I) -> TwItem { return tw_expert(I, w_e1, w_e2, (unsigned char*)W1e, (unsigned char*)W2e, lane, wave); };
            TW_LOOP(true, NT_TAIL / 8 + (bx - 128), NT_TAIL / 8 + 128 * GU_R, 128, dec_ex, 64.f);
            __syncthreads(); } }
    SEAM(PH_GU);
    if (IN(PH_DN)) for (int rep_ = 0; rep_ < REPS[PH_DN]; ++rep_) { if (rep_) xcd_barrier(bar); DenseOrder S; S.init(T_, 1024, G, bx); EpiResB<true> E{hB, hA, 1024}; gemm_phase<EpiResB<true>, DenseOrder, true>(lds, zb, Wdn, 1408, S, E, 121, 125); }
    SEAM(PH_DN);
    if (IN(PH_NORM3)) for (int rep_ = 0; rep_ < REPS[PH_NORM3]; ++rep_) { if (rep_) xcd_barrier(bar); PH_IDS(); const float* g_in = ARG_IN(14); for (int m = gw; m < T_; m += 8 * NGW) { f32x4 v[8][4]; rms_rows<8, true, true>(hB, g_in, hn, m, NGW, lane, v); } }
    SEAM(PH_NORM3);
    if (IN(PH_QKV)) for (int rep_ = 0; rep_ < REPS[PH_QKV]; ++rep_) { if (rep_) xcd_barrier(bar); DenseOrder S; S.init(T_, 3072, G, bx); EpiQkvMoba E{zb, ARG_IN(16), ARG_IN(17), ropec, ropes, kmean, lds + 131072}; gemm_phase<EpiQkvMoba, DenseOrder, true>(lds, hn, Wqkv, 512, S, E, 121, 127); }

    SEAM(PH_QKV);
    if (IN(PH_ATTN1)) for (int rep_ = 0; rep_ < REPS[PH_ATTN1]; ++rep_) { if (rep_) xcd_barrier(bar);
        for (int L = bx; L < 512; L += G) { const int bh = L >> 4, x = (L < 256) ? (L & 15) : 15 - (L & 15), b = bh >> 3, h = bh & 7;
            const bf16_t* base = zb + (size_t)b * 4096 * 3072 + h * 128;
            at::attn_unit<1, 3072, 1024>(base, base + 1024, base + 2048, mixb + (size_t)b * 4096 * 1024 + h * 128, kmean + (size_t)bh * 16 * 128, 2 * x, 2 * x + 1, (LAS char*)lds); }
    }
    SEAM(PH_ATTN1);
    if (IN(PH_OUT1)) for (int rep_ = 0; rep_ < REPS[PH_OUT1]; ++rep_) { if (rep_) xcd_barrier(bar); DenseOrder S; S.init(T_, 1024, G, bx); EpiResB<true> E{hA, hB, 1024}; gemm_phase(lds, mixb, Wout1, 1024, S, E); }
    SEAM(PH_OUT1);
    if (IN(PH_ROUTE)) { PH_IDS();
        LAS float* wr_l = (LAS float*)lds;
        LAS int* tk = (LAS int*)(lds + 32768);
        LAS int* pos = (LAS int*)(lds + 32768 + 256);
        LAS int* ebase = (LAS int*)(lds + 32768 + 1024);
        const float* w_r = ARG_IN(20); const float* g19 = ARG_IN(19);
        for (int i = tid; i < 8 * 1024; i += 512) { const int e = i >> 10, k = i & 1023; wr_l[i] = w_r[k * 8 + e]; }
        __syncthreads();
        for (int g0 = bx * 64; g0 < T_; g0 += G * 64) {
            for (int rr = 0; rr < 8; ++rr) {
                const int tl = wave * 8 + rr, m = g0 + tl;
                f32x4 v[1][4]; rms_rows<1, true, true>(hA, g19, hn, m, 0, lane, v);
                float l[8];
#pragma unroll
                for (int e = 0; e < 8; ++e) { float s = 0.f;
#pragma unroll
                    for (int q = 0; q < 4; ++q) { const f32x4 w4 = *(const LAS f32x4*)(wr_l + e * 1024 + 256 * q + 4 * lane); s += (v[0][q].x * w4.x + v[0][q].y * w4.y) + (v[0][q].z * w4.z + v[0][q].w * w4.w); }
                    l[e] = wave_sum(s); }
                int i0 = 0; float b0 = l[0];
#pragma unroll
                for (int e = 1; e < 8; ++e) if (l[e] > b0) { b0 = l[e]; i0 = e; }
                int i1 = -1; float b1 = -INFINITY;
#pragma unroll
                for (int e = 0; e < 8; ++e) if (e != i0 && (i1 < 0 || l[e] > b1)) { b1 = l[e]; i1 = e; }
                if (lane == 0) { const float e1 = expf(b1 - b0); gate[(size_t)m * 2] = 1.f / (1.f + e1); gate[(size_t)m * 2 + 1] = e1 / (1.f + e1); tk[tl] = i0 | (i1 << 8); }
            }
            __syncthreads();
            if (tid < 8) { int c = 0; for (int t = 0; t < 64; ++t) { const int p = tk[t]; if ((p & 255) == tid) pos[t * 2] = c++; if ((p >> 8) == tid) pos[t * 2 + 1] = c++; }
                ebase[tid] = c ? atomicAdd(&cnt[tid], c) : 0; }
            __syncthreads();
            if (tid < 128) { const int t = tid >> 1, s = tid & 1; const int p = tk[t]; const int e = s ? (p >> 8) : (p & 255); idx[e * ECAP + ebase[e] + pos[t * 2 + s]] = (g0 + t) * 2 + s; }
            __syncthreads();
        }
    }
    SEAM(PH_ROUTE);
    if (IN(PH_MOE1)) for (int rep_ = 0; rep_ < REPS[PH_MOE1]; ++rep_) { if (rep_) xcd_barrier(bar); MoeOrder S{28, G, bx, cnt, idx}; EpiSwiglu8 E{(unsigned char*)zb, 3584, 4.f}; gemm_phase<EpiSwiglu8, MoeOrder, true>(lds, hn, W1e, 512, S, E, 121, 127); }
    SEAM(PH_MOE1);
    if (IN(PH_MOE2)) for (int rep_ = 0; rep_ < REPS[PH_MOE2]; ++rep_) { if (rep_) xcd_barrier(bar); MoeOrder S{4, G, bx, cnt, nullptr}; EpiMoeOut E{ybuf, idx}; gemm_phase<EpiMoeOut, MoeOrder, true>(lds, zb, W2e, 1792, S, E, 121, 125); }
    SEAM(PH_MOE2);
    if (IN(PH_COMB)) for (int rep_ = 0; rep_ < REPS[PH_COMB]; ++rep_) { if (rep_) xcd_barrier(bar); PH_IDS();
        float* o_out = ARG_OUT;
        for (int m = gw; m < T_; m += NGW) {
            const float g0 = gate[(size_t)m * 2], g1 = gate[(size_t)m * 2 + 1];
            const u32x2* hr = (const u32x2*)(hA + (size_t)m * D_) + lane; f32x4* orow = (f32x4*)(o_out + (size_t)m * D_) + lane;
            const u32x2* y0 = (const u32x2*)(ybuf + (size_t)m * D_) + lane; const u32x2* y1 = (const u32x2*)(ybuf + (size_t)(T_ + m) * D_) + lane;
#pragma unroll
            for (int j = 0; j < 4; ++j) { const u32x2 hb_ = hr[64 * j]; f32x4 h; h.x = __uint_as_float(hb_.x << 16); h.y = __uint_as_float(hb_.x & 0xffff0000u); h.z = __uint_as_float(hb_.y << 16); h.w = __uint_as_float(hb_.y & 0xffff0000u); const u32x2 a = y0[64 * j], b = y1[64 * j];
                f32x4 o; o.x = h.x + g0 * __uint_as_float(a.x << 16) + g1 * __uint_as_float(b.x << 16); o.y = h.y + g0 * __uint_as_float(a.x & 0xffff0000u) + g1 * __uint_as_float(b.x & 0xffff0000u);
                o.z = h.z + g0 * __uint_as_float(a.y << 16) + g1 * __uint_as_float(b.y << 16); o.w = h.w + g0 * __uint_as_float(a.y & 0xffff0000u) + g1 * __uint_as_float(b.y & 0xffff0000u);
                orow[64 * j] = o; }
        }
    }
#undef IN
#undef ws
#undef ctl
#undef cnt
#undef idx
#undef gate
#undef zs
#undef hn
#undef mixb
#undef hA
#undef hB
#undef zb
#undef ybuf
#undef fneg
#undef kmean
#undef ropec
#undef ropes
}
}


extern "C" void kernel_launch(void* const* d_in, const int* in_sizes, int n_in, void* d_out, int out_size, void* d_ws, size_t ws_size, hipStream_t st) {
    static bool attr_done = false;
    if (!attr_done) { attr_done = true; (void)hipFuncSetAttribute((const void*)mk::mk_fwd, hipFuncAttributeMaxDynamicSharedMemorySize, mk::LDS_BYTES); }
    mk::Args a; memset(&a, 0, sizeof(a));
    for (int i = 0; i < 23; ++i) a.in[i] = (const float*)d_in[i];
    a.out = (float*)d_out; a.ws = (unsigned char*)d_ws;
    (void)hipMemsetAsync((char*)d_ws + mk::WS_CTL, 0, mk::CTL_ZERO_BYTES, st);
    a.ph_lo = 0; a.ph_hi = mk::PH_END;
    hipLaunchKernelGGL(mk::mk_fwd, dim3(256), dim3(512), mk::LDS_BYTES, st, a);
}
```

```cpp
#include <hip/hip_runtime.h>
#include <stdint.h>
#include <math.h>
#include <string.h>
namespace at {
#define LAS __attribute__((address_space(3)))
typedef unsigned short bf16_t;
typedef short bf16x8 __attribute__((ext_vector_type(8)));
typedef short s16x4 __attribute__((ext_vector_type(4)));
typedef float f32x16 __attribute__((ext_vector_type(16)));
typedef float f32x4 __attribute__((ext_vector_type(4)));
typedef unsigned u32x4 __attribute__((ext_vector_type(4)));
constexpr float SCALE = 0.08838834764831845f;
constexpr float THR = 8.f;
constexpr int NW = 8, QBLK = 32, KVBLK = 64, D = 128, SEQL = 4096;
constexpr int SHM_V = KVBLK * D * 2, SHM_K = KVBLK * D * 2;
constexpr int OFF_WS = 2 * SHM_V + 2 * SHM_K;
constexpr int OFF_BIAS = OFF_WS + NW * 64 * 4;
constexpr int ATTN_LDS = OFF_BIAS + SEQL * 4;

#define KSWZ(row, colB) ((row) * 256 + ((colB) ^ (((row) & 7) << 4)))
#define SBAR() __builtin_amdgcn_sched_barrier(0)
__device__ __forceinline__ int v_st(int k, int c) { const int kk = (k & ~0xC) | ((k & 4) << 1) | ((k & 8) >> 1); return ((kk >> 3) * 4 + (c >> 5)) * 512 + ((kk & 7) * 32 + (c & 31)) * 2; }
__device__ __forceinline__ int v_rd_base(int lane) { return ((lane & 3) << 3) | (((lane >> 2) & 3) << 6) | (((lane >> 4) & 1) << 5) | (((lane >> 5) & 1) << 8); }
constexpr int v_rd_off(int d0, int ks, int half) { return d0 * 512 + ks * 4096 + half * 2048; }
__device__ __forceinline__ int crow(int r, int hi) { return (r & 3) + 8 * (r >> 2) + 4 * hi; }
__device__ __forceinline__ unsigned cvtpk(float lo, float hi) { unsigned r; asm volatile("v_cvt_pk_bf16_f32 %0, %1, %2" : "=v"(r) : "v"(lo), "v"(hi)); return r; }
__device__ __forceinline__ bf16x8 load8(const bf16_t* p) { return *reinterpret_cast<const bf16x8*>(p); }

__device__ __forceinline__ void mask_tile(f32x16& p0, f32x16& p1, int dq) {
    const float NEG = -__builtin_inff();
#pragma unroll
    for (int r = 0; r < 16; ++r) {
        const int c = (r & 3) + 8 * (r >> 2);
        if (dq - c < 0) p0[r] = NEG;
        if (dq - c - 32 < 0) p1[r] = NEG;
    }
}
__device__ __forceinline__ void partialSM(f32x16& p0, f32x16& p1, float& m_reg, float& mn, float& alpha) {
    float pmax = p0[0]; for (int r = 1; r < 16; ++r) pmax = fmaxf(pmax, p0[r]); for (int r = 0; r < 16; ++r) pmax = fmaxf(pmax, p1[r]);
    { auto rr = __builtin_amdgcn_permlane32_swap(__float_as_uint(pmax), __float_as_uint(pmax), false, false);
      pmax = fmaxf(__uint_as_float(rr[0]), __uint_as_float(rr[1])); }
    constexpr float C2 = 1.4426950408889634f * SCALE;
    if (__builtin_expect(__all((pmax - m_reg) * SCALE <= THR), 1)) { mn = m_reg; alpha = 1.f; }
    else { mn = fmaxf(m_reg, pmax); alpha = __builtin_amdgcn_exp2f((m_reg - mn) * C2); m_reg = mn; }
    const float mnL = -mn * C2;
    for (int r = 0; r < 16; ++r) p0[r] = fmaf(p0[r], C2, mnL); for (int r = 0; r < 16; ++r) p1[r] = fmaf(p1[r], C2, mnL);
    for (int r = 0; r < 16; ++r) p0[r] = __builtin_amdgcn_exp2f(p0[r]);
}
__device__ __forceinline__ void finishSM(f32x16& p0, f32x16& p1, float alpha, float& l_reg, bf16x8& pa0, bf16x8& pa1, bf16x8& pa2, bf16x8& pa3) {
    for (int r = 0; r < 16; ++r) p1[r] = __builtin_amdgcn_exp2f(p1[r]);
    float ps = 0; for (int r = 0; r < 16; ++r) ps += p0[r]; for (int r = 0; r < 16; ++r) ps += p1[r];
    { auto rr = __builtin_amdgcn_permlane32_swap(__float_as_uint(ps), __float_as_uint(ps), false, false);
      ps = __uint_as_float(rr[0]) + __uint_as_float(rr[1]); }
    l_reg = l_reg * alpha + ps;
#define PK4(P, B_, OUT) do { unsigned a0 = cvtpk(P[B_+0], P[B_+1]), a1 = cvtpk(P[B_+2], P[B_+3]);                          \
        unsigned b0 = cvtpk(P[B_+4], P[B_+5]), b1 = cvtpk(P[B_+6], P[B_+7]);                                             \
        auto r0 = __builtin_amdgcn_permlane32_swap(a0, b0, false, false); auto r1 = __builtin_amdgcn_permlane32_swap(a1, b1, false, false); \
        u32x4 w = {r0[0], r1[0], r0[1], r1[1]}; OUT = *reinterpret_cast<bf16x8*>(&w); } while (0)
    PK4(p0, 0, pa0); PK4(p0, 8, pa1); PK4(p1, 0, pa2); PK4(p1, 8, pa3);
#undef PK4
}
template <int KB, int MODE>
__device__ __forceinline__ void qkt(f32x16& p0, f32x16& p1, LAS const char* K_lds, int r32, int hi, const bf16x8* qr, bool act, LAS const float* bias_kb) {
    if (!act) { const float NEG = -__builtin_inff();
#pragma unroll
        for (int r = 0; r < 16; ++r) { p0[r] = NEG; p1[r] = NEG; } return; }
    if (MODE == 0) {
#pragma unroll
        for (int g = 0; g < 4; ++g) { const f32x4 b0 = *(LAS const f32x4*)(bias_kb + 8 * g + 4 * hi), b1 = *(LAS const f32x4*)(bias_kb + 32 + 8 * g + 4 * hi);
#pragma unroll
            for (int j = 0; j < 4; ++j) { p0[4 * g + j] = b0[j]; p1[4 * g + j] = b1[j]; } }
    } else { p0 = f32x16{}; p1 = f32x16{}; }
    LAS const char* kb[4];
#pragma unroll
    for (int dd = 0; dd < 4; ++dd) kb[dd] = K_lds + KB * SHM_K + KSWZ(r32, (dd * 16 + hi * 8) * 2);
#pragma unroll
    for (int d0 = 0; d0 < 8; ++d0) { LAS const char* a = kb[d0 & 3] + (d0 >> 2) * 128;
        bf16x8 b0 = *(LAS const bf16x8*)(a);
        bf16x8 b1 = *(LAS const bf16x8*)(a + 32 * 256);
        p0 = __builtin_amdgcn_mfma_f32_32x32x16_bf16(b0, qr[d0], p0, 0, 0, 0);
        p1 = __builtin_amdgcn_mfma_f32_32x32x16_bf16(b1, qr[d0], p1, 0, 0, 0); }
}
template <int VB>
__device__ __forceinline__ void pv_tile(f32x16* o, int vb0, bf16x8 pa0, bf16x8 pa1, bf16x8 pa2, bf16x8 pa3, bool act) {
    if (!act) return;
#define TRRD(dst, off) asm volatile("ds_read_b64_tr_b16 %0, %1 offset:%2" : "=&v"(dst) : "v"(vb0), "i"(off) : "memory")
#define PV_D0(d0) do { s16x4 l0, l1, l2, l3, h0, h1, h2, h3; constexpr int b_ = VB * SHM_V + v_rd_off(d0, 0, 0); \
        TRRD(l0, b_); TRRD(h0, b_ + 2048); TRRD(l1, b_ + 4096); TRRD(h1, b_ + 6144); TRRD(l2, b_ + 8192); TRRD(h2, b_ + 10240); TRRD(l3, b_ + 12288); TRRD(h3, b_ + 14336); \
        asm volatile("s_waitcnt lgkmcnt(0)" ::: "memory"); SBAR();   \
        o[d0] = __builtin_amdgcn_mfma_f32_32x32x16_bf16(pa0, (bf16x8){l0[0], l0[1], l0[2], l0[3], h0[0], h0[1], h0[2], h0[3]}, o[d0], 0, 0, 0);   \
        o[d0] = __builtin_amdgcn_mfma_f32_32x32x16_bf16(pa1, (bf16x8){l1[0], l1[1], l1[2], l1[3], h1[0], h1[1], h1[2], h1[3]}, o[d0], 0, 0, 0);   \
        o[d0] = __builtin_amdgcn_mfma_f32_32x32x16_bf16(pa2, (bf16x8){l2[0], l2[1], l2[2], l2[3], h2[0], h2[1], h2[2], h2[3]}, o[d0], 0, 0, 0);   \
        o[d0] = __builtin_amdgcn_mfma_f32_32x32x16_bf16(pa3, (bf16x8){l3[0], l3[1], l3[2], l3[3], h3[0], h3[1], h3[2], h3[3]}, o[d0], 0, 0, 0); } while (0)
    PV_D0(0); PV_D0(1); PV_D0(2); PV_D0(3);
#undef PV_D0
#undef TRRD
}

template <int MODE, int PITCH, int OP>
__device__ __forceinline__ void attn_unit(const bf16_t* Q, const bf16_t* K, const bf16_t* V, bf16_t* O, const float* aux, int pa, int pb, LAS char* lds) {
    const int tid = threadIdx.x; const int wid = __builtin_amdgcn_readfirstlane(tid >> 6), lane = tid & 63, r32 = lane & 31, hi = lane >> 5;
    int jlo = 0, NT = 2 * (pb + 1);
    const int qlo = 128 * (wid < 4 ? pa : pb) + 32 * (wid & 3), qm = qlo + r32 - 4 * hi;
    LAS char* V_lds = lds; LAS char* K_lds = lds + 2 * SHM_V;
    LAS float* wsf = (LAS float*)(lds + OFF_WS) + wid * 64; LAS float* li_l = wsf; LAS float* al_l = wsf + 32;
    LAS float* auxl = (LAS float*)(lds + OFF_BIAS);
    float m_reg = -1e30f, l_reg = 0; f32x16 o[4] = {};
    const int sr = tid >> 4, sc = (tid & 15) * 8, vst0 = v_st(sr, sc), vst1 = v_st(32 + sr, sc), kws = KSWZ(sr, sc * 2);
    const int vb0 = (int)(unsigned)(uintptr_t)V_lds + v_rd_base(lane);
    bf16x8 qr[8]; bf16x8 st_v0, st_v1, st_k0, st_k1;
#define ROW(p, k0, rr) ((const bf16_t*)((const char*)(p) + (unsigned)((((k0) + (rr)) * PITCH + sc) * 2)))
#define VMW() asm volatile("s_waitcnt vmcnt(0)" ::: "memory")
#define SLOAD_H(k0) do { st_v0 = load8(ROW(V, k0, sr)); st_v1 = load8(ROW(V, k0, 32 + sr)); st_k0 = load8(ROW(K, k0, sr)); st_k1 = load8(ROW(K, k0, 32 + sr)); } while (0)
#define SWRITE_HK(bf) do { *(LAS bf16x8*)(K_lds + (bf) * SHM_K + kws) = st_k0; *(LAS bf16x8*)(K_lds + (bf) * SHM_K + kws + 32 * 256) = st_k1; } while (0)
#define SWRITE_HV(bf) do { *(LAS bf16x8*)(V_lds + (bf) * SHM_V + vst0) = st_v0; *(LAS bf16x8*)(V_lds + (bf) * SHM_V + vst1) = st_v1; } while (0)
#define SWRITE_H(bf) do { SWRITE_HV(bf); SWRITE_HK(bf); } while (0)
#pragma unroll
    for (int d0 = 0; d0 < 8; ++d0) qr[d0] = load8((const bf16_t*)((const char*)Q + (unsigned)(((qlo + r32) * PITCH + d0 * 16 + hi * 8) * 2)));
    if (MODE == 0) { for (int i = tid; i < (pb + 1) * 128 / 4; i += 512) ((LAS f32x4*)auxl)[i] = ((const f32x4*)aux)[i]; }
    else { for (int i = tid; i < 16 * 128 / 4; i += 512) ((LAS f32x4*)auxl)[i] = ((const f32x4*)aux)[i]; }
    if (MODE == 0) {
        __syncthreads();
        const float thr = aux[4096], f0 = auxl[128 * pa];
        const int j = lane < NT ? lane : NT - 1;
        const unsigned long long bal = __ballot(lane < NT && (f0 - auxl[64 * j + 63]) > thr);
        jlo = __builtin_amdgcn_readfirstlane(__popcll(bal)) & ~1; if (jlo > NT - 2) jlo = NT - 2;
        NT -= jlo;
    }
    SLOAD_H(jlo * KVBLK); VMW(); SWRITE_HK(0);
    __syncthreads();
    unsigned selm = 0u, wsel = 0u; const int curw = qlo >> 8;
    if (MODE == 1) {
        float g[16];
#pragma unroll
        for (int j = 0; j < 16; ++j) g[j] = 0.f;
#pragma unroll
        for (int d0 = 0; d0 < 8; ++d0) {
            float qf[8];
#pragma unroll
            for (int e = 0; e < 8; ++e) qf[e] = __uint_as_float(((unsigned)(unsigned short)qr[d0][e]) << 16);
#pragma unroll
            for (int j = 0; j < 15; ++j) { if (j < curw) { const f32x4 k0 = *(LAS const f32x4*)(auxl + j * 128 + d0 * 16 + hi * 8), k1 = *(LAS const f32x4*)(auxl + j * 128 + d0 * 16 + hi * 8 + 4);
                g[j] += (qf[0] * k0[0] + qf[1] * k0[1]) + (qf[2] * k0[2] + qf[3] * k0[3]) + (qf[4] * k1[0] + qf[5] * k1[1]) + (qf[6] * k1[2] + qf[7] * k1[3]); } }
        }
#pragma unroll
        for (int j = 0; j < 15; ++j) { auto rr = __builtin_amdgcn_permlane32_swap(__float_as_uint(g[j]), __float_as_uint(g[j]), false, false); g[j] = __uint_as_float(rr[0]) + __uint_as_float(rr[1]); }
#pragma unroll
        for (int k = 0; k < 3; ++k) { int best = -1; float bv = -__builtin_inff();
#pragma unroll
            for (int j = 0; j < 15; ++j) if (j < curw && !((selm >> j) & 1u) && g[j] > bv) { bv = g[j]; best = j; }
            if (best >= 0) selm |= 1u << best; }
#pragma unroll
        for (int j = 0; j < 15; ++j) if (__any((selm >> j) & 1u)) wsel |= 1u << j;
        wsel = __builtin_amdgcn_readfirstlane(wsel);
    }
#define KBASE(t) ((jlo + (t)) * KVBLK)
#define ACT(t) (KBASE(t) <= qlo + QBLK - 1 && (MODE == 0 || (KBASE(t) >> 8) == curw || ((wsel >> (KBASE(t) >> 8)) & 1u)))
#define MASKT(P0_, P1_, t) do { const int kb_ = KBASE(t); if (ACT(t)) { if (kb_ + KVBLK - 1 > qlo) mask_tile(P0_, P1_, qm - kb_); \
        if (MODE == 1 && (kb_ >> 8) < curw && !((selm >> (kb_ >> 8)) & 1u)) { const float NEG_ = -__builtin_inff(); _Pragma("unroll") for (int r_ = 0; r_ < 16; ++r_) { P0_[r_] = NEG_; P1_[r_] = NEG_; } } } } while (0)
#define RESC(a) do { if (__any((a) < 1.f)) { if (hi == 0) al_l[r32] = (a); asm volatile("s_waitcnt lgkmcnt(0)" ::: "memory");              \
                     for (int d_ = 0; d_ < 4; ++d_) for (int r = 0; r < 16; ++r) o[d_][r] *= al_l[crow(r, hi)]; } } while (0)
    f32x16 pA0, pA1, pB0, pB1; float mnA, mnB, alA, alB; bf16x8 pa0, pa1, pa2, pa3;
    SWRITE_HV(0); SBAR();
    SLOAD_H(KBASE(1));
    SBAR(); qkt<0, MODE>(pA0, pA1, K_lds, r32, hi, qr, ACT(0), auxl + KBASE(0));
    MASKT(pA0, pA1, 0); partialSM(pA0, pA1, m_reg, mnA, alA);
    VMW(); SWRITE_H(1);
    __syncthreads();
#define HALF_STEP(PX0, PX1, mnX, alX, PY0, PY1, alY, t, KB, VB, SB) do {                                                      \
        SBAR(); qkt<KB, MODE>(PX0, PX1, K_lds, r32, hi, qr, ACT(t), auxl + KBASE(t));                                         \
        finishSM(PY0, PY1, alY, l_reg, pa0, pa1, pa2, pa3); SBAR();                                                           \
        if ((t) + 1 < NT) { SLOAD_H(KBASE((t) + 1)); SBAR(); }                                                                \
        pv_tile<VB>(o, vb0, pa0, pa1, pa2, pa3, ACT((t) - 1)); MASKT(PX0, PX1, (t)); partialSM(PX0, PX1, m_reg, mnX, alX);    \
        __syncthreads();                                                                                                      \
        if ((t) + 1 < NT) { VMW(); SWRITE_H(SB); }                                                                            \
        RESC(alX); __syncthreads(); } while (0)
    for (int t = 1; t + 1 < NT; t += 2) {
        HALF_STEP(pB0, pB1, mnB, alB, pA0, pA1, alA, t, 1, 0, 0);
        HALF_STEP(pA0, pA1, mnA, alA, pB0, pB1, alB, t + 1, 0, 1, 1);
    }
    SBAR(); qkt<1, MODE>(pB0, pB1, K_lds, r32, hi, qr, ACT(NT - 1), auxl + KBASE(NT - 1)); SBAR();
    finishSM(pA0, pA1, alA, l_reg, pa0, pa1, pa2, pa3); SBAR();
    pv_tile<0>(o, vb0, pa0, pa1, pa2, pa3, ACT(NT - 2));
    MASKT(pB0, pB1, NT - 1); partialSM(pB0, pB1, m_reg, mnB, alB); __syncthreads(); RESC(alB);
    finishSM(pB0, pB1, alB, l_reg, pa0, pa1, pa2, pa3); SBAR(); pv_tile<1>(o, vb0, pa0, pa1, pa2, pa3, ACT(NT - 1));
    SBAR();
    if (hi == 0) li_l[r32] = l_reg; asm volatile("s_waitcnt lgkmcnt(0)" ::: "memory");
    float rli[16];
#pragma unroll
    for (int r = 0; r < 16; ++r) rli[r] = __builtin_amdgcn_rcpf(li_l[crow(r, hi)]);
    bf16_t* Ow = O + (size_t)qlo * OP;
#pragma unroll
    for (int r = 0; r < 16; ++r) { const int orow = crow(r, hi);
#pragma unroll
        for (int d0 = 0; d0 < 4; ++d0) { const float v = o[d0][r] * rli[r];
            const float vn = __shfl_xor(v, 1);
            if ((r32 & 1) == 0) *(unsigned*)(Ow + (size_t)orow * OP + d0 * 32 + r32) = cvtpk(v, vn); } }
    __syncthreads();
#undef RESC
#undef KBASE
#undef ACT
#undef MASKT
#undef HALF_STEP
#undef ROW
#undef VMW
#undef SLOAD_H
#undef SWRITE_HK
#undef SWRITE_HV
#undef SWRITE_H
}
#undef KSWZ
#undef SBAR
#undef LAS
}
namespace gd {
#ifndef GD_DBG_BEGIN
#define GD_DBG_BEGIN(k)
#define GD_DBG_END(k)
#endif
#define LAS __attribute__((address_space(3)))
typedef unsigned short bf16_t;
typedef short bf16x8 __attribute__((ext_vector_type(8)));
typedef float f32x16 __attribute__((ext_vector_type(16)));
typedef float f32x4 __attribute__((ext_vector_type(4)));
typedef float f32x2 __attribute__((ext_vector_type(2)));
typedef unsigned u32x4 __attribute__((ext_vector_type(4)));
typedef unsigned u32x2 __attribute__((ext_vector_type(2)));
constexpr int G_QS = 0, G_K = 16384, G_KGT = 32768, G_RHS = 49152, G_M = 114688, G_ATT = 131072, G_SC = 139264, G_RS = 139264 + 1024;
__device__ __forceinline__ unsigned cvtpk(float lo, float hi) { unsigned r; asm volatile("v_cvt_pk_bf16_f32 %0, %1, %2" : "=v"(r) : "v"(lo), "v"(hi)); return r; }
__device__ __forceinline__ float bflo(unsigned u) { return __uint_as_float(u << 16); }
__device__ __forceinline__ float bfhi(unsigned u) { return __uint_as_float(u & 0xffff0000u); }
__device__ __forceinline__ float silu_f(float x) { return x * __builtin_amdgcn_rcpf(1.f + __builtin_amdgcn_exp2f(-1.4426950408889634f * x)); }
__device__ __forceinline__ int off256(int row, int ch) { return row * 256 + ((ch ^ (row & 15)) << 4); }
__device__ __forceinline__ int off128(int row, int ch) { return row * 128 + ((ch ^ (row & 7)) << 4); }
__device__ __forceinline__ int crow(int r, int hi) { return (r & 3) + 8 * (r >> 2) + 4 * hi; }
#define GD_BAR() do { asm volatile("s_waitcnt lgkmcnt(0)" ::: "memory"); __builtin_amdgcn_s_barrier(); asm volatile("" ::: "memory"); } while (0)

__device__ __forceinline__ f32x16 mma64(LAS const char* A, int arow, LAS const char* B, int brow, int lane) {
    const int r = lane & 31, hi = lane >> 5; f32x16 acc = {};
#pragma unroll
    for (int s = 0; s < 4; ++s) {
        const bf16x8 a = *(LAS const bf16x8*)(A + off128(arow + r, 2 * s + hi)), b = *(LAS const bf16x8*)(B + off128(brow + r, 2 * s + hi));
        acc = __builtin_amdgcn_mfma_f32_32x32x16_bf16(a, b, acc, 0, 0, 0);
    }
    return acc;
}

 constexpr int GD_R1 = 1, GD_R2 = 1, GD_R3 = 1, GD_R4 = 1;
struct GdnBufs { bf16_t* T; float* RT; bf16_t* ST; bf16_t* QT; float* OL; };

__device__ __forceinline__ void gdn_chunk(int ci, const bf16_t* zb, const float* zs, const float* convw, const float* a_log, const float* dt_bias, const GdnBufs& gb, LAS char* lds_in) {
    unsigned lb_ = (unsigned)(uintptr_t)lds_in; asm volatile("" : "+v"(lb_)); LAS char* lds = (LAS char*)(uintptr_t)lb_;
    int tid = threadIdx.x; asm volatile("" : "+v"(tid)); const int lane = tid & 63, wave = __builtin_amdgcn_readfirstlane(tid >> 6);
    const int bh = ci >> 6, c = ci & 63, b = bh >> 2, h = bh & 3;
    const size_t tok0 = (size_t)b * 4096 + c * 64;
    LAS float* sc_gc = (LAS float*)(lds + G_SC); LAS float* sc_beta = sc_gc + 64; LAS float* sc_eg = sc_gc + 128; LAS float* sc_egl = sc_gc + 192;
    LAS float* rsv = (LAS float*)(lds + G_RS);
    LAS float* part = (LAS float*)(lds + G_ATT);
    const int cg = tid % 48, rg = tid / 48, which = cg >> 4, d0 = (cg & 15) * 8, r0 = rg * 8;
    const int col = 1536 + which * 512 + h * 128 + d0, chn = which * 512 + h * 128 + d0;
#define GD_LOADW() float w[4][8]; _Pragma("unroll") for (int i = 0; i < 4; ++i) { const f32x4 a_ = *(const f32x4*)(convw + i * 1536 + chn), b_ = *(const f32x4*)(convw + i * 1536 + chn + 4); \
        w[i][0] = a_[0]; w[i][1] = a_[1]; w[i][2] = a_[2]; w[i][3] = a_[3]; w[i][4] = b_[0]; w[i][5] = b_[1]; w[i][6] = b_[2]; w[i][7] = b_[3]; }
#define GD_LOADRAW() u32x4 raw[11]; _Pragma("unroll") for (int j = 0; j < 11; ++j) { const int row_ = r0 - 3 + j; const bool ok_ = (c * 64 + row_) >= 0; \
        raw[j] = ok_ ? *(const u32x4*)(zb + (tok0 + row_) * 3584 + col) : (u32x4){0u, 0u, 0u, 0u}; }
#define GD_CONVROW(rr, y8) _Pragma("unroll") for (int e = 0; e < 8; ++e) { float a_ = 0.f; _Pragma("unroll") for (int i = 0; i < 4; ++i) { const unsigned uu = raw[(rr) + i][e >> 1]; const float xv = (e & 1) ? bfhi(uu) : bflo(uu); a_ = fmaf(w[i][e], xv, a_); } y8[e] = silu_f(a_); }
    unsigned yp[8][4];
    if (tid < 384) {
        GD_LOADW(); GD_LOADRAW();
#pragma unroll
        for (int rr = 0; rr < 8; ++rr) { float y8[8]; GD_CONVROW(rr, y8);
            yp[rr][0] = cvtpk(y8[0], y8[1]); yp[rr][1] = cvtpk(y8[2], y8[3]); yp[rr][2] = cvtpk(y8[4], y8[5]); yp[rr][3] = cvtpk(y8[6], y8[7]);
            if (which < 2) { float ss = 0.f;
#pragma unroll
                for (int e = 0; e < 8; ++e) ss += y8[e] * y8[e];
                part[(which * 64 + r0 + rr) * 16 + (cg & 15)] = ss; } }
    } else if (wave == 6) {
        const int row = lane; const float ga = zs[(tok0 + row) * 12 + 4 + h], gbv = zs[(tok0 + row) * 12 + 8 + h];
        const float xs = ga + dt_bias[h]; const float sp = xs > 20.f ? xs : log1pf(expf(xs));
        const float g = -expf(a_log[h]) * sp; const float beta = 1.f / (1.f + expf(-gbv));
        float inc = g;
#pragma unroll
        for (int o = 1; o < 64; o <<= 1) { const float t = __shfl_up(inc, o); if (lane >= o) inc += t; }
        const float gl = __shfl(inc, 63);
        sc_gc[row] = inc; sc_beta[row] = beta; sc_eg[row] = expf(inc); sc_egl[row] = expf(gl - inc);
    }
    __syncthreads();
    if (tid < 128) { const LAS float* p = part + tid * 16; float s = 0.f;
#pragma unroll
        for (int i = 0; i < 16; ++i) s += p[i];
        rsv[tid] = rsqrtf(s + 1e-6f); }
    __syncthreads();
    if (tid < 384) {
#pragma unroll
        for (int rr = 0; rr < 8; ++rr) { const int row = r0 + rr; float y8[8];
#pragma unroll
            for (int e = 0; e < 8; ++e) y8[e] = (e & 1) ? bfhi(yp[rr][e >> 1]) : bflo(yp[rr][e >> 1]);
            if (which == 0) { const float f = rsv[row] * 0.08838834764831845f;
                u32x4 o; o.x = cvtpk(y8[0] * f, y8[1] * f); o.y = cvtpk(y8[2] * f, y8[3] * f); o.z = cvtpk(y8[4] * f, y8[5] * f); o.w = cvtpk(y8[6] * f, y8[7] * f);
                *(LAS u32x4*)(lds + G_QS + off256(row, d0 >> 3)) = o;
            } else if (which == 1) { const float f = rsv[64 + row], be = sc_beta[row] * sc_eg[row], el = sc_egl[row];
                float kv[8];
#pragma unroll
                for (int e = 0; e < 8; ++e) kv[e] = y8[e] * f;
                u32x4 o; o.x = cvtpk(kv[0], kv[1]); o.y = cvtpk(kv[2], kv[3]); o.z = cvtpk(kv[4], kv[5]); o.w = cvtpk(kv[6], kv[7]);
                *(LAS u32x4*)(lds + G_K + off256(row, d0 >> 3)) = o;
                LAS float* rp = (LAS float*)(lds + G_RHS) + row * 256 + 128 + d0;
                *(LAS f32x4*)rp = (f32x4){kv[0] * be, kv[1] * be, kv[2] * be, kv[3] * be}; *(LAS f32x4*)(rp + 4) = (f32x4){kv[4] * be, kv[5] * be, kv[6] * be, kv[7] * be};
#pragma unroll
                for (int e = 0; e < 8; e += 2) { const unsigned pk = cvtpk(kv[e] * el, kv[e + 1] * el);
                    *(LAS unsigned short*)(lds + G_KGT + off128(d0 + e, rg) + rr * 2) = (unsigned short)(pk & 0xffffu);
                    *(LAS unsigned short*)(lds + G_KGT + off128(d0 + e + 1, rg) + rr * 2) = (unsigned short)(pk >> 16); }
            } else { const float be = sc_beta[row];
                LAS float* rp = (LAS float*)(lds + G_RHS) + row * 256 + d0;
                *(LAS f32x4*)rp = (f32x4){y8[0] * be, y8[1] * be, y8[2] * be, y8[3] * be}; *(LAS f32x4*)(rp + 4) = (f32x4){y8[4] * be, y8[5] * be, y8[6] * be, y8[7] * be}; }
        }
    }
#undef GD_LOADW
#undef GD_LOADRAW
#undef GD_CONVROW
    __syncthreads();
    for (int r2_ = 0; r2_ < GD_R2; ++r2_) {
        const int whichm = wave >> 2, ts = (wave >> 1) & 1, tc = wave & 1, r = lane & 31, hi = lane >> 5;
        const int cc = 32 * tc + r; const float gcc = sc_gc[cc], bec = sc_beta[cc];
        f32x16 acc = {};
        const bool live = tc >= ts;
        if (live) {
            LAS const char* Xi = lds + (whichm ? G_QS : G_K);
#pragma unroll
            for (int s8 = 0; s8 < 8; ++s8) {
                const bf16x8 a = *(LAS const bf16x8*)(lds + G_K + off256(32 * ts + r, 2 * s8 + hi)), bb = *(LAS const bf16x8*)(Xi + off256(cc, 2 * s8 + hi));
                acc = __builtin_amdgcn_mfma_f32_32x32x16_bf16(a, bb, acc, 0, 0, 0); }
        }
        if (whichm == 0) {
            if (live) {
#pragma unroll
                for (int g = 0; g < 4; ++g) { const int s4 = 32 * ts + 8 * g + 4 * hi; const f32x4 gs = *(LAS const f32x4*)(sc_gc + s4); f32x4 o;
#pragma unroll
                    for (int j = 0; j < 4; ++j) o[j] = (cc > s4 + j) ? bec * acc[4 * g + j] * __expf(gcc - gs[j]) : 0.f;
                    *(LAS f32x4*)(lds + G_M + cc * 256 + s4 * 4) = o; }
            }
        } else {
#pragma unroll
            for (int g = 0; g < 4; ++g) { const int s4 = 32 * ts + 8 * g + 4 * hi; const f32x4 gs = *(LAS const f32x4*)(sc_gc + s4); float o[4];
#pragma unroll
                for (int j = 0; j < 4; ++j) o[j] = (live && cc >= s4 + j) ? acc[4 * g + j] * __expf(gcc - gs[j]) : 0.f;
                u32x2 w2; w2.x = cvtpk(o[0], o[1]); w2.y = cvtpk(o[2], o[3]);
                *(LAS u32x2*)(lds + G_ATT + off128(cc, s4 >> 3) + (s4 & 7) * 2) = w2; }
        }
    }
    __syncthreads();
    if (wave < 4) {
        float x[64];
        const LAS float* rhs = (const LAS float*)(lds + G_RHS) + tid; const LAS float* Mm = (const LAS float*)(lds + G_M);
        f32x4 mA[16], mB[16];
#define GD_LDM(buf, row_) { _Pragma("unroll") for (int q_ = 0; q_ < ((row_) + 3) / 4; ++q_) buf[q_] = *(const LAS f32x4*)(Mm + (row_) * 64 + 4 * q_); }
#define GD_ROW(buf, row_) { float a0 = rhs[(row_) * 256], a1 = 0.f, a2 = 0.f, a3 = 0.f; \
            _Pragma("unroll") for (int q_ = 0; q_ < (row_) / 4; ++q_) { a0 = fmaf(-buf[q_][0], x[4 * q_], a0); a1 = fmaf(-buf[q_][1], x[4 * q_ + 1], a1); a2 = fmaf(-buf[q_][2], x[4 * q_ + 2], a2); a3 = fmaf(-buf[q_][3], x[4 * q_ + 3], a3); \
                asm("" : "+v"(a0), "+v"(a1), "+v"(a2), "+v"(a3)); } \
            if (((row_) & 3) > 0) a0 = fmaf(-buf[(row_) / 4][0], x[((row_) & ~3)], a0); \
            if (((row_) & 3) > 1) a1 = fmaf(-buf[(row_) / 4][1], x[((row_) & ~3) + 1], a1); \
            if (((row_) & 3) > 2) a2 = fmaf(-buf[(row_) / 4][2], x[((row_) & ~3) + 2], a2); \
            x[row_] = (a0 + a1) + (a2 + a3); }
        for (int r3_ = 0; r3_ < GD_R3; ++r3_) {
        GD_LDM(mA, 0);
#pragma clang loop unroll(full)
        for (int cr = 0; cr < 64; cr += 2) {
            GD_LDM(mB, cr + 1); asm volatile("" ::: "memory");
            GD_ROW(mA, cr); asm volatile("" ::: "memory");
            if (cr + 2 < 64) { GD_LDM(mA, cr + 2); } asm volatile("" ::: "memory");
            GD_ROW(mB, cr + 1); asm volatile("" ::: "memory");
        }
        }
#undef GD_LDM
#undef GD_ROW
        __syncthreads();
        LAS char* dst = lds + (tid < 128 ? G_K : G_M); const int colr = tid & 127;
#pragma unroll
        for (int ch = 0; ch < 8; ++ch) { u32x4 o; o.x = cvtpk(x[8 * ch], x[8 * ch + 1]); o.y = cvtpk(x[8 * ch + 2], x[8 * ch + 3]); o.z = cvtpk(x[8 * ch + 4], x[8 * ch + 5]); o.w = cvtpk(x[8 * ch + 6], x[8 * ch + 7]);
            *(LAS u32x4*)(dst + off128(colr, ch)) = o; }
    } else { __syncthreads(); }
    __syncthreads();
    for (int r4_ = 0; r4_ < GD_R4; ++r4_) {
    {
        LAS const char* UT = lds + G_K; LAS const char* WT = lds + G_M; LAS const char* KGT = lds + G_KGT; LAS const char* ATT = lds + G_ATT;
        const int r = lane & 31, hi = lane >> 5;
        const float gl = sc_eg[63];
        {
            const int dt = wave >> 1, tt = wave & 1, tok = 32 * tt + r; const float eg = sc_eg[tok];
            const f32x16 acc = mma64(WT, 32 * dt, ATT, 32 * tt, lane);
#pragma unroll
            for (int g = 0; g < 4; ++g) { const int d4 = 32 * dt + 8 * g + 4 * hi; bf16_t* qrow = gb.QT + (((size_t)ci * 32 + (d4 >> 2)) * 64 + tok) * 4 - d4;
                const u32x2 q2 = *(LAS const u32x2*)(lds + G_QS + off256(tok, d4 >> 3) + (d4 & 7) * 2);
                u32x2 o; o.x = cvtpk(bflo(q2.x) * eg - acc[4 * g], bfhi(q2.x) * eg - acc[4 * g + 1]); o.y = cvtpk(bflo(q2.y) * eg - acc[4 * g + 2], bfhi(q2.y) * eg - acc[4 * g + 3]);
                *(u32x2*)(qrow + d4) = o; }
        }
        {
            const int dt = wave >> 1, tt = wave & 1, tok = 32 * tt + r;
            const f32x16 acc = mma64(UT, 32 * dt, ATT, 32 * tt, lane);
#pragma unroll
            for (int g = 0; g < 4; ++g) { const int dg = 8 * dt + 2 * g + hi; *(f32x4*)(gb.OL + (((size_t)ci * 32 + dg) * 64 + tok) * 4) = (f32x4){acc[4 * g], acc[4 * g + 1], acc[4 * g + 2], acc[4 * g + 3]}; }
        }
#pragma unroll
        for (int i2 = 0; i2 < 2; ++i2) {
            const int id = wave + 8 * i2, kt = id >> 2, it = id & 3, irow = 32 * it + r;
            const f32x16 acc = mma64(WT, 32 * kt, KGT, 32 * it, lane);
#pragma unroll
            for (int g = 0; g < 4; ++g) { const int k4 = 32 * kt + 8 * g + 4 * hi; float o[4];
#pragma unroll
                for (int j = 0; j < 4; ++j) o[j] = ((irow == k4 + j) ? gl : 0.f) - acc[4 * g + j];
                u32x2 w2; w2.x = cvtpk(o[0], o[1]); w2.y = cvtpk(o[2], o[3]);
                const int pg = 4 * (2 * kt + (g >> 1)) + 2 * hi + (g & 1); *(u32x2*)(gb.T + (((size_t)ci * 32 + pg) * 128 + irow) * 4) = w2; }
        }
#pragma unroll
        for (int i2 = 0; i2 < 2; ++i2) {
            const int id = wave + 8 * i2, it = id >> 2, jt = id & 3, jcol = 32 * jt + r;
            const f32x16 acc = mma64(KGT, 32 * it, UT, 32 * jt, lane);
#pragma unroll
            for (int g = 0; g < 4; ++g) { const int ig = 8 * it + 2 * g + hi; *(f32x4*)(gb.RT + (((size_t)ci * 32 + ig) * 128 + jcol) * 4) = (f32x4){acc[4 * g], acc[4 * g + 1], acc[4 * g + 2], acc[4 * g + 3]}; }
        }
    }
    }
    GD_BAR();
}

__device__ __forceinline__ void gdn_scan(int bh, int half, const GdnBufs& gb, LAS char* lds) {
    int tid = threadIdx.x; asm volatile("" : "+v"(tid)); const int lane = tid & 63, wave = __builtin_amdgcn_readfirstlane(tid >> 6), r = lane & 31, hi = lane >> 5;
    constexpr int TBS = 32768, RB = 2 * TBS, RBS = 16384;
    if (wave >= 4) {
        const int t = tid - 256;
        u32x4 stA[8], stB[8]; f32x4 srA[4], srB[4]; const unsigned toff = (unsigned)t * 16u;
        const unsigned roff = (unsigned)(((t >> 5) * 128 + 32 * half + (t & 31)) * 16);
        const bf16_t* T0 = gb.T + (size_t)(bh * 64) * 16384; const float* R0 = gb.RT + (size_t)(bh * 64) * 16384;
#define GD_LT(st, c_) { const char* p_ = (const char*)(T0 + (size_t)(c_) * 16384); _Pragma("unroll") for (int n = 0; n < 8; ++n) st[n] = *(const u32x4*)(p_ + n * 4096 + toff); }
#define GD_WT(st, c_) { LAS char* q_ = lds + ((c_) & 1) * TBS + toff; _Pragma("unroll") for (int n = 0; n < 8; ++n) *(LAS u32x4*)(q_ + n * 4096) = st[n]; }
#define GD_LR(sr, c_) { const char* p_ = (const char*)(R0 + (size_t)(c_) * 16384); _Pragma("unroll") for (int n = 0; n < 4; ++n) sr[n] = *(const f32x4*)(p_ + n * 16384 + roff); }
#define GD_WR(sr, c_) { LAS char* q_ = lds + RB + ((c_) & 1) * RBS + toff; _Pragma("unroll") for (int n = 0; n < 4; ++n) *(LAS f32x4*)(q_ + n * 4096) = sr[n]; }
        GD_LT(stA, 0); GD_LR(srA, 0); GD_WT(stA, 0); GD_WR(srA, 0); GD_LT(stA, 1); GD_LR(srA, 1); GD_LT(stB, 2); GD_LR(srB, 2);
        for (int c = 0; c < 64; c += 2) {
            GD_BAR();
            GD_WT(stA, c + 1); GD_WR(srA, c + 1); if (c + 3 < 64) { GD_LT(stA, c + 3); GD_LR(srA, c + 3); }
            GD_BAR();
            if (c + 2 < 64) { GD_WT(stB, c + 2); GD_WR(srB, c + 2); if (c + 4 < 64) { GD_LT(stB, c + 4); GD_LR(srB, c + 4); } }
        }
#undef GD_LT
#undef GD_WT
#undef GD_LR
#undef GD_WR
    } else if (wave >= 1) {
        for (int c = 0; c < 64; ++c) { GD_BAR(); }
    } else {
        f32x16 S[4] = {};
        const int col = 32 * half + r;
        for (int c = 0; c < 64; ++c) {
            const int ci = bh * 64 + c;
            bf16_t* stb = gb.ST + ((size_t)ci * 32 * 128 + col) * 4;
            bf16x8 bfr[4][2];
#pragma unroll
            for (int tl = 0; tl < 4; ++tl)
#pragma unroll
                for (int s = 0; s < 2; ++s) { u32x4 w4; w4.x = cvtpk(S[tl][8 * s], S[tl][8 * s + 1]); w4.y = cvtpk(S[tl][8 * s + 2], S[tl][8 * s + 3]); w4.z = cvtpk(S[tl][8 * s + 4], S[tl][8 * s + 5]); w4.w = cvtpk(S[tl][8 * s + 6], S[tl][8 * s + 7]);
                    bfr[tl][s] = *reinterpret_cast<bf16x8*>(&w4);
                    u32x2 lo2; lo2.x = w4.x; lo2.y = w4.y; u32x2 hi2; hi2.x = w4.z; hi2.y = w4.w;
                    *(u32x2*)(stb + (size_t)(8 * tl + 4 * s + hi) * 512) = lo2; *(u32x2*)(stb + (size_t)(8 * tl + 4 * s + hi + 2) * 512) = hi2; }
            GD_BAR();
            LAS const char* Tb = lds + (c & 1) * TBS + (2 * hi * 128 + r) * 8;
            LAS const char* Rb = lds + RB + (c & 1) * RBS + (hi * 32 + r) * 16;
            bf16x8 afA[8], afB[8]; f32x4 rvA[4], rvB[4];
#define GD_LDT(af, rv, it_) { _Pragma("unroll") for (int q = 0; q < 8; ++q) { const u32x2 l_ = *(LAS const u32x2*)(Tb + q * 4096 + (it_) * 256), h_ = *(LAS const u32x2*)(Tb + q * 4096 + (it_) * 256 + 1024); \
                                  u32x4 w_; w_.x = l_.x; w_.y = l_.y; w_.z = h_.x; w_.w = h_.y; af[q] = *reinterpret_cast<bf16x8*>(&w_); } \
                              _Pragma("unroll") for (int g = 0; g < 4; ++g) rv[g] = *(LAS const f32x4*)(Rb + (8 * (it_) + 2 * g) * 512); }
#define GD_MMT(af, rv, it_) { f32x16 acc = {}; _Pragma("unroll") for (int q = 0; q < 8; ++q) acc = __builtin_amdgcn_mfma_f32_32x32x16_bf16(af[q], bfr[q >> 1][q & 1], acc, 0, 0, 0); \
                              _Pragma("unroll") for (int g = 0; g < 4; ++g) _Pragma("unroll") for (int j = 0; j < 4; ++j) S[it_][4 * g + j] = acc[4 * g + j] + rv[g][j]; }
            GD_LDT(afA, rvA, 0); __builtin_amdgcn_sched_barrier(0);
            GD_LDT(afB, rvB, 1); __builtin_amdgcn_sched_barrier(0);
            GD_MMT(afA, rvA, 0); __builtin_amdgcn_sched_barrier(0);
            GD_LDT(afA, rvA, 2); __builtin_amdgcn_sched_barrier(0);
            GD_MMT(afB, rvB, 1); __builtin_amdgcn_sched_barrier(0);
            GD_LDT(afB, rvB, 3); __builtin_amdgcn_sched_barrier(0);
            GD_MMT(afA, rvA, 2); __builtin_amdgcn_sched_barrier(0);
            GD_MMT(afB, rvB, 3);
#undef GD_LDT
#undef GD_MMT
        }
    }
    GD_BAR();
}

__device__ __forceinline__ void gdn_out(int ci, const GdnBufs& gb, const bf16_t* zb, const float* onorm, bf16_t* mix, LAS char* lds) {
    int tid = threadIdx.x; asm volatile("" : "+v"(tid)); const int lane = tid & 63, wave = __builtin_amdgcn_readfirstlane(tid >> 6), r = lane & 31, hi = lane >> 5;
    const int bh = ci >> 6, c = ci & 63, b = bh >> 2, h = bh & 3;
    const int dt = wave >> 1, tt = wave & 1, tok = 32 * tt + r;
    const size_t m = (size_t)b * 4096 + c * 64 + tok;
    LAS float* ssq = (LAS float*)lds;
    const bf16_t* Ab = gb.ST + ((size_t)ci * 32 * 128 + 32 * dt + r) * 4;
    const bf16_t* Bb = gb.QT + ((size_t)ci * 32 * 64 + tok) * 4;
    const float* Ob = gb.OL + ((size_t)ci * 32 * 64 + tok) * 4;
    const bf16_t* grow = zb + m * 3584 + 3072 + h * 128; bf16_t* mrow = mix + m * 1024 + 512 + h * 128;
    u32x2 g2_[4]; f32x4 on_[4];
#pragma unroll
    for (int g = 0; g < 4; ++g) { const int d4 = 32 * dt + 8 * g + 4 * hi; g2_[g] = *(const u32x2*)(grow + d4); on_[g] = *(const f32x4*)(onorm + d4); }
    f32x16 acc;
#pragma unroll
    for (int g = 0; g < 4; ++g) { const f32x4 v = *(const f32x4*)(Ob + (size_t)(8 * dt + 2 * g + hi) * 256); acc[4 * g] = v[0]; acc[4 * g + 1] = v[1]; acc[4 * g + 2] = v[2]; acc[4 * g + 3] = v[3]; }
#pragma unroll
    for (int s = 0; s < 8; ++s) { const int kg = 4 * s + 2 * hi;
        const u32x2 a0 = *(const u32x2*)(Ab + (size_t)kg * 512), a1 = *(const u32x2*)(Ab + (size_t)(kg + 1) * 512), b0 = *(const u32x2*)(Bb + (size_t)kg * 256), b1 = *(const u32x2*)(Bb + (size_t)(kg + 1) * 256);
        u32x4 aw; aw.x = a0.x; aw.y = a0.y; aw.z = a1.x; aw.w = a1.y; u32x4 bw; bw.x = b0.x; bw.y = b0.y; bw.z = b1.x; bw.w = b1.y;
        acc = __builtin_amdgcn_mfma_f32_32x32x16_bf16(*reinterpret_cast<bf16x8*>(&aw), *reinterpret_cast<bf16x8*>(&bw), acc, 0, 0, 0); }
    float ss = 0.f;
#pragma unroll
    for (int i = 0; i < 16; ++i) ss += acc[i] * acc[i];
    { auto rr = __builtin_amdgcn_permlane32_swap(__float_as_uint(ss), __float_as_uint(ss), false, false); ss = __uint_as_float(rr[0]) + __uint_as_float(rr[1]); }
    if (hi == 0) ssq[tok * 4 + dt] = ss;
    __syncthreads();
    const f32x4 s4 = *(LAS const f32x4*)(ssq + tok * 4);
    const float rs = rsqrtf(((s4[0] + s4[1]) + (s4[2] + s4[3])) * (1.f / 128.f) + 1e-6f);
#pragma unroll
    for (int g = 0; g < 4; ++g) { const int d4 = 32 * dt + 8 * g + 4 * hi;
        const u32x2 g2 = g2_[g]; const f32x4 on = on_[g];
        const float o0 = acc[4 * g] * rs * on[0] * silu_f(bflo(g2.x)), o1 = acc[4 * g + 1] * rs * on[1] * silu_f(bfhi(g2.x)), o2 = acc[4 * g + 2] * rs * on[2] * silu_f(bflo(g2.y)), o3 = acc[4 * g + 3] * rs * on[3] * silu_f(bfhi(g2.y));
        u32x2 w2; w2.x = cvtpk(o0, o1); w2.y = cvtpk(o2, o3); *(u32x2*)(mrow + d4) = w2; }
    GD_BAR();
}
#undef GD_BAR
#undef LAS
}
namespace mk {
#define LAS __attribute__((address_space(3)))
#define GAS __attribute__((address_space(1)))
typedef unsigned short bf16_t;
typedef short bf16x8 __attribute__((ext_vector_type(8)));
typedef float f32x4 __attribute__((ext_vector_type(4)));
typedef float f32x2 __attribute__((ext_vector_type(2)));
typedef unsigned u32x4 __attribute__((ext_vector_type(4)));
typedef unsigned u32x2 __attribute__((ext_vector_type(2)));
constexpr int BM = 256, BK = 64, HALF = 128, HTB = HALF * BK * 2, STAGE_BYTES = 8 * HTB, NXCD = 8, WGM = 8;
constexpr int NWAVES = 8;
constexpr int T_ = 16384, D_ = 1024;
constexpr int ECAP = 16384;

__host__ __device__ __forceinline__ int lds_byte(int r, int c) { const int st = (r >> 4) * 2 + (c >> 5), rr = r & 15, cc = c & 31, ob = rr * 64 + cc * 2; return st * 1024 + (ob ^ (((ob >> 9) & 1) << 5)); }
__host__ __device__ __forceinline__ void stage_rc(int b, int& R, int& C) { const int st = b / 1024, sb = b % 1024, swz = sb ^ (((sb >> 9) & 1) << 5); R = (st >> 1) * 16 + swz / 64; C = (st & 1) * 32 + (swz % 64) / 2; }
__host__ __device__ __forceinline__ int perm32(int rho) { const int n = rho >> 4, i = rho & 15; return 8 * (i >> 2) + 4 * n + (i & 3); }
__device__ __forceinline__ unsigned cvt_pk_bf16(float lo, float hi) { unsigned r; asm volatile("v_cvt_pk_bf16_f32 %0, %1, %2" : "=v"(r) : "v"(lo), "v"(hi)); return r; }
__device__ __forceinline__ unsigned pk4_fp8(float a, float b, float c, float d) { unsigned w = 0; w = __builtin_amdgcn_cvt_pk_fp8_f32(a, b, w, false); w = __builtin_amdgcn_cvt_pk_fp8_f32(c, d, w, true); return w; }
__device__ __forceinline__ float bf2f(unsigned short b) { return __uint_as_float(((unsigned)b) << 16); }
__device__ __forceinline__ float silu_f(float x) { return x * __builtin_amdgcn_rcpf(1.f + __builtin_amdgcn_exp2f(-1.4426950408889634f * x)); }
__device__ __forceinline__ f32x2 swiglu_pk(f32x2 g, f32x2 u, float s) {
    const f32x2 t = g * (-1.4426950408889634f); f32x2 e; e.x = __builtin_amdgcn_exp2f(t.x); e.y = __builtin_amdgcn_exp2f(t.y);
    const f32x2 d = e + 1.0f; f32x2 r; r.x = __builtin_amdgcn_rcpf(d.x); r.y = __builtin_amdgcn_rcpf(d.y);
    return (g * r) * (u * s);
}
#define DPP_F(old_, v_, ctrl_, rmask_) __int_as_float(__builtin_amdgcn_update_dpp(__float_as_int(old_), __float_as_int(v_), ctrl_, rmask_, 0xf, false))
__device__ __forceinline__ float wave_sum(float v) {
    v += DPP_F(0.f, v, 0xb1, 0xf);
    v += DPP_F(0.f, v, 0x4e, 0xf);
    v += DPP_F(0.f, v, 0x141, 0xf);
    v += DPP_F(0.f, v, 0x140, 0xf);
    v += DPP_F(0.f, v, 0x142, 0xa);
    v += DPP_F(0.f, v, 0x143, 0xc);
    return __int_as_float(__builtin_amdgcn_readlane(__float_as_int(v), 63));
}

struct Unit { int pm, pn, po, rows, e, mt; };

struct DenseOrder {
    int nM, nN, nwg, G, c;
    __device__ void init(int M, int N, int G_, int c_) { nM = M / BM; nN = N / BM; nwg = nM * nN; G = G_; c = c_; }
    __device__ bool next(int i, Unit& u) const {
        const long L = (long)i * G + c; if (L >= nwg) return false;
        int wgid = (int)L; { const int q = nwg / NXCD, r = nwg % NXCD, xcd = wgid % NXCD, off = wgid / NXCD; wgid = (xcd < r ? xcd * (q + 1) : r * (q + 1) + (xcd - r) * q) + off; }
        const int nig = WGM * nN, gid = wgid / nig, fm = gid * WGM, gsz = (nM - fm) < WGM ? (nM - fm) : WGM;
        u.pm = fm + ((wgid % nig) % gsz); u.pn = (wgid % nig) / gsz; u.po = u.pn; u.rows = 256; u.e = 0; u.mt = 0; return true;
    }
    __device__ __forceinline__ int arow(const Unit& u, int r) const { return u.pm * BM + r; }
};
struct QkvOrder {
    int G, c;
    __device__ bool next(int i, Unit& u) const {
        if (G != 256) { DenseOrder d; d.init(T_, 3072, G, c); return d.next(i, u); }
        if (i >= 3) return false;
        const int nN = i < 2 ? 8 : 4, nwg = 64 * nN; int wgid = i < 2 ? i * 256 + c : c;
        { const int q = nwg / NXCD, xcd = wgid % NXCD, off = wgid / NXCD; wgid = xcd * q + off; }
        const int nig = WGM * nN, gid = wgid / nig, fm = gid * WGM;
        u.pm = fm + ((wgid % nig) % WGM); u.pn = (wgid % nig) / WGM + (i < 2 ? 0 : 8); u.po = u.pn; u.rows = 256; u.e = 0; u.mt = 0; return true;
    }
    __device__ __forceinline__ int arow(const Unit& u, int r) const { return u.pm * BM + r; }
};
struct MoeOrder {
    int nN, G, c; const int* cnt; const int* idx;
    __device__ bool next(int i, Unit& u) const {
        int cj[8]; int nM = 0;
#pragma unroll
        for (int j = 0; j < 8; ++j) { cj[j] = __hip_atomic_load(cnt + 64 * j, __ATOMIC_RELAXED, __HIP_MEMORY_SCOPE_AGENT); nM += (cj[j] + 255) >> 8; }
        const long L = (long)i * G + c; if (L >= (long)nM * nN) return false;
        const int nig = WGM * nN, gid = (int)(L / nig), fm = gid * WGM, gsz = (nM - fm) < WGM ? (nM - fm) : WGM, w = (int)(L % nig);
        const int pmg = fm + (w % gsz), pnl = w / gsz;
        int t = pmg, e = 0, rows = 0; bool found = false;
#pragma unroll
        for (int j = 0; j < 8; ++j) { const int ntj = (cj[j] + 255) >> 8; if (!found) { if (t < ntj) { found = true; e = j; const int rem = cj[j] - t * 256; rows = rem < 256 ? rem : 256; } else t -= ntj; } }
        u.pm = pmg; u.e = e; u.mt = t; u.pn = e * nN + pnl; u.po = pnl; u.rows = rows; return true;
    }
    __device__ __forceinline__ int arow(const Unit& u, int r) const {
        if (idx) return r < u.rows ? (idx[u.e * ECAP + u.mt * 256 + r] >> 1) : 0;
        return u.pm * BM + r;
    }
};

struct EpiBf16 {
    static constexpr bool PERM = true;
    bf16_t* O; int ldc;
    __device__ __forceinline__ void operator()(const f32x4 (&acc)[2][2][4][2], const Unit& u, int wr, int wc, int fr, int fq) const {
        const int row0 = u.pm * BM + wr * 64 + fr, col0 = u.po * BM + wc * 32 + 8 * fq;
#pragma unroll
        for (int ai = 0; ai < 2; ++ai)
#pragma unroll
            for (int m = 0; m < 4; ++m) { bf16_t* rowp = O + (size_t)(row0 + ai * HALF + m * 16) * ldc + col0;
#pragma unroll
                for (int bj = 0; bj < 2; ++bj) { const f32x4 v0 = acc[ai][bj][m][0], v1 = acc[ai][bj][m][1];
                    u32x4 w; w.x = cvt_pk_bf16(v0[0], v0[1]); w.y = cvt_pk_bf16(v0[2], v0[3]); w.z = cvt_pk_bf16(v1[0], v1[1]); w.w = cvt_pk_bf16(v1[2], v1[3]);
                    *(u32x4*)(rowp + bj * HALF) = w; } }
    }
};
struct EpiResF32 {
    static constexpr bool PERM = false;
    float* C; const float* res; int ldc;
    __device__ __forceinline__ void operator()(const f32x4 (&acc)[2][2][4][2], const Unit& u, int wr, int wc, int fr, int fq) const {
        const int row0 = u.pm * BM + wr * 64 + fr, col0 = u.po * BM + wc * 32 + 4 * fq;
#pragma unroll
        for (int ai = 0; ai < 2; ++ai)
#pragma unroll
            for (int m = 0; m < 4; ++m) { const size_t off = (size_t)(row0 + ai * HALF + m * 16) * ldc + col0;
#pragma unroll
                for (int bj = 0; bj < 2; ++bj)
#pragma unroll
                    for (int n = 0; n < 2; ++n) { const f32x4 r = *(const f32x4*)(res + off + bj * HALF + n * 16); *(f32x4*)(C + off + bj * HALF + n * 16) = acc[ai][bj][m][n] + r; }
                asm volatile("" ::: "memory"); }
    }
};
template <bool RES_BF16> struct EpiResB {
    static constexpr bool PERM = true;
    bf16_t* O; const void* res; int ldc;
    __device__ __forceinline__ void operator()(const f32x4 (&acc)[2][2][4][2], const Unit& u, int wr, int wc, int fr, int fq) const {
        const int row0 = u.pm * BM + wr * 64 + fr, col0 = u.po * BM + wc * 32 + 8 * fq;
#pragma unroll
        for (int ai = 0; ai < 2; ++ai)
#pragma unroll
            for (int m = 0; m < 4; ++m) { const size_t off = (size_t)(row0 + ai * HALF + m * 16) * ldc + col0;
#pragma unroll
                for (int bj = 0; bj < 2; ++bj) { f32x4 v0 = acc[ai][bj][m][0], v1 = acc[ai][bj][m][1];
                    if (RES_BF16) { const u32x4 r = *(const u32x4*)((const bf16_t*)res + off + bj * HALF);
                        v0[0] += __uint_as_float(r.x << 16); v0[1] += __uint_as_float(r.x & 0xffff0000u); v0[2] += __uint_as_float(r.y << 16); v0[3] += __uint_as_float(r.y & 0xffff0000u);
                        v1[0] += __uint_as_float(r.z << 16); v1[1] += __uint_as_float(r.z & 0xffff0000u); v1[2] += __uint_as_float(r.w << 16); v1[3] += __uint_as_float(r.w & 0xffff0000u); }
                    else { const float* rp = (const float*)res + off + bj * HALF; v0 += *(const f32x4*)rp; v1 += *(const f32x4*)(rp + 4); }
                    u32x4 w; w.x = cvt_pk_bf16(v0[0], v0[1]); w.y = cvt_pk_bf16(v0[2], v0[3]); w.z = cvt_pk_bf16(v1[0], v1[1]); w.w = cvt_pk_bf16(v1[2], v1[3]);
                    *(u32x4*)(O + off + bj * HALF) = w; }
                asm volatile("" ::: "memory"); }
    }
};
struct EpiSwiglu {
    static constexpr bool PERM = true;
    bf16_t* O; int ldo;
    __device__ __forceinline__ void operator()(const f32x4 (&acc)[2][2][4][2], const Unit& u, int wr, int wc, int fr, int fq) const {
        const int row0 = u.pm * BM + wr * 64 + fr, col0 = u.po * HALF + wc * 32 + 8 * fq;
#pragma unroll
        for (int ai = 0; ai < 2; ++ai)
#pragma unroll
            for (int m = 0; m < 4; ++m) { bf16_t* rowp = O + (size_t)(row0 + ai * HALF + m * 16) * ldo + col0;
                const f32x4 g0 = acc[ai][0][m][0], g1 = acc[ai][0][m][1], u0 = acc[ai][1][m][0], u1 = acc[ai][1][m][1];
                float v[8];
#pragma unroll
                for (int j = 0; j < 4; j += 2) { const f32x2 a = swiglu_pk((f32x2){g0[j], g0[j + 1]}, (f32x2){u0[j], u0[j + 1]}, 1.f), b = swiglu_pk((f32x2){g1[j], g1[j + 1]}, (f32x2){u1[j], u1[j + 1]}, 1.f);
                    v[j] = a.x; v[j + 1] = a.y; v[4 + j] = b.x; v[5 + j] = b.y; }
                u32x4 w; w.x = cvt_pk_bf16(v[0], v[1]); w.y = cvt_pk_bf16(v[2], v[3]); w.z = cvt_pk_bf16(v[4], v[5]); w.w = cvt_pk_bf16(v[6], v[7]);
                *(u32x4*)rowp = w; }
    }
};
struct EpiSwiglu8 {
    static constexpr bool PERM = true;
    unsigned char* O; int ldo; float oscale;
    __device__ __forceinline__ void operator()(const f32x4 (&acc)[2][2][4][2], const Unit& u, int wr, int wc, int fr, int fq) const {
        const int row0 = u.pm * BM + wr * 64 + fr, col0 = u.po * HALF + wc * 32 + 8 * fq;
#pragma unroll
        for (int ai = 0; ai < 2; ++ai)
#pragma unroll
            for (int m = 0; m < 4; ++m) { unsigned char* rowp = O + (size_t)(row0 + ai * HALF + m * 16) * ldo + col0;
                const f32x4 g0 = acc[ai][0][m][0], g1 = acc[ai][0][m][1], u0 = acc[ai][1][m][0], u1 = acc[ai][1][m][1];
                float v[8];
#pragma unroll
                for (int j = 0; j < 4; j += 2) { const f32x2 a = swiglu_pk((f32x2){g0[j], g0[j + 1]}, (f32x2){u0[j], u0[j + 1]}, oscale), b = swiglu_pk((f32x2){g1[j], g1[j + 1]}, (f32x2){u1[j], u1[j + 1]}, oscale);
                    v[j] = a.x; v[j + 1] = a.y; v[4 + j] = b.x; v[5 + j] = b.y; }
                u32x2 w; w.x = pk4_fp8(v[0], v[1], v[2], v[3]); w.y = pk4_fp8(v[4], v[5], v[6], v[7]);
                *(u32x2*)rowp = w; }
    }
};
struct EpiQkvMoba {
    static constexpr bool PERM = true, AFTER_DRAIN = false;
    bf16_t* O; const float* qg; const float* kg; const float* ropec; const float* ropes; float* kmean; LAS unsigned char* xl;
    __device__ __forceinline__ void operator()(const f32x4 (&acc)[2][2][4][2], const Unit& u, int wr, int wc, int fr, int fq) const {
        const int t = u.po;
        if (t >= 8) {
            const int row0 = u.pm * BM + wr * 64 + fr, col0 = t * BM + wc * 32 + 8 * fq;
#pragma unroll
            for (int ai = 0; ai < 2; ++ai)
#pragma unroll
                for (int m = 0; m < 4; ++m) { bf16_t* rowp = O + (size_t)(row0 + ai * HALF + m * 16) * 3072 + col0;
#pragma unroll
                    for (int bj = 0; bj < 2; ++bj) { const f32x4 v0 = acc[ai][bj][m][0], v1 = acc[ai][bj][m][1];
                        u32x4 w; w.x = cvt_pk_bf16(v0[0], v0[1]); w.y = cvt_pk_bf16(v0[2], v0[3]); w.z = cvt_pk_bf16(v1[0], v1[1]); w.w = cvt_pk_bf16(v1[2], v1[3]);
                        *(u32x4*)(rowp + bj * HALF) = w; } }
            return;
        }
        LAS float* P = (LAS float*)xl;
        LAS float* ks = (LAS float*)(xl + 4096);
        int tid = threadIdx.x; asm volatile("" : "+v"(tid)); const bool isk = t >= 4;
        if (tid < 256) ks[tid] = 0.f;
        LAS float* gl_ = (LAS float*)(xl + 5120);
        if (tid < 128) gl_[tid] = (isk ? kg : qg)[tid];
#pragma unroll
        for (int ai = 0; ai < 2; ++ai)
#pragma unroll
            for (int m = 0; m < 4; ++m) { float ss = 0.f;
#pragma unroll
                for (int bj = 0; bj < 2; ++bj)
#pragma unroll
                    for (int n = 0; n < 2; ++n) { const f32x4 v = acc[ai][bj][m][n]; ss += (v[0] * v[0] + v[1] * v[1]) + (v[2] * v[2] + v[3] * v[3]); }
                ss += __shfl_xor(ss, 16); ss += __shfl_xor(ss, 32);
                if (fq == 0) P[(ai * HALF + wr * 64 + m * 16 + fr) * 4 + wc] = ss; }
        asm volatile("s_waitcnt lgkmcnt(0)" ::: "memory"); __builtin_amdgcn_s_barrier(); asm volatile("" ::: "memory");
        const int hs = wc >> 1, dl0 = 32 * (wc & 1) + 8 * fq;
        const int rl0 = wr * 64 + fr, pos0 = (u.pm * BM + rl0) & 4095;
        f32x4 csN = *(const f32x4*)(ropec + pos0 * 64 + dl0), snN = *(const f32x4*)(ropes + pos0 * 64 + dl0);
#pragma unroll
        for (int ai = 0; ai < 2; ++ai)
#pragma unroll
            for (int m = 0; m < 4; ++m) { const int rl = ai * HALF + m * 16 + rl0, row = u.pm * BM + rl;
                const float rs = rsqrtf((P[rl * 4 + 2 * hs] + P[rl * 4 + 2 * hs + 1]) * (1.f / 128.f) + 1e-6f);
                u32x4 wl, wh;
#pragma unroll
                for (int q4 = 0; q4 < 2; ++q4) {
                    const f32x4 cs = csN, sn = snN;
                    { const int i1 = (ai * 4 + m) * 2 + q4 + 1; if (i1 < 16) { const int p1 = pos0 + 128 * (i1 >> 3) + 16 * ((i1 >> 1) & 3), d1 = dl0 + 4 * (i1 & 1); csN = *(const f32x4*)(ropec + p1 * 64 + d1); snN = *(const f32x4*)(ropes + p1 * 64 + d1); } }
                    const f32x4 ga = *(const LAS f32x4*)(gl_ + dl0 + 4 * q4), gb = *(const LAS f32x4*)(gl_ + 64 + dl0 + 4 * q4);
                    const f32x4 a = acc[ai][0][m][q4] * rs * ga, b = acc[ai][1][m][q4] * rs * gb;
                    const f32x4 lo = a * cs - b * sn, hi = b * cs + a * sn;
                    if (q4 == 0) { wl.x = cvt_pk_bf16(lo[0], lo[1]); wl.y = cvt_pk_bf16(lo[2], lo[3]); wh.x = cvt_pk_bf16(hi[0], hi[1]); wh.y = cvt_pk_bf16(hi[2], hi[3]); }
                    else { wl.z = cvt_pk_bf16(lo[0], lo[1]); wl.w = cvt_pk_bf16(lo[2], lo[3]); wh.z = cvt_pk_bf16(hi[0], hi[1]); wh.w = cvt_pk_bf16(hi[2], hi[3]); }
                    asm volatile("" ::: "memory"); }
                bf16_t* rowp = O + (size_t)row * 3072 + t * BM + hs * 128 + dl0;
                *(u32x4*)rowp = wl; *(u32x4*)(rowp + 64) = wh;
                asm volatile("" ::: "memory"); }
        if (isk) {
            asm volatile("s_waitcnt vmcnt(0)" ::: "memory"); __builtin_amdgcn_s_barrier(); asm volatile("" ::: "memory");
            const int c8 = tid & 31, rg = tid >> 5; float cs8[8];
#pragma unroll
            for (int e = 0; e < 8; ++e) cs8[e] = 0.f;
            const bf16_t* src = O + (size_t)(u.pm * BM + rg * 16) * 3072 + t * BM + c8 * 8;
#pragma unroll
            for (int r = 0; r < 16; ++r) { const u32x4 raw = *(const u32x4*)(src + (size_t)r * 3072);
                cs8[0] += __uint_as_float(raw.x << 16); cs8[1] += __uint_as_float(raw.x & 0xffff0000u); cs8[2] += __uint_as_float(raw.y << 16); cs8[3] += __uint_as_float(raw.y & 0xffff0000u);
                cs8[4] += __uint_as_float(raw.z << 16); cs8[5] += __uint_as_float(raw.z & 0xffff0000u); cs8[6] += __uint_as_float(raw.w << 16); cs8[7] += __uint_as_float(raw.w & 0xffff0000u); }
#pragma unroll
            for (int e = 0; e < 8; ++e) atomicAdd((float*)(ks + c8 * 8 + e), cs8[e]);
            asm volatile("s_waitcnt lgkmcnt(0)" ::: "memory"); __builtin_amdgcn_s_barrier(); asm volatile("" ::: "memory");
            if (tid < 256) { const int head = (t - 4) * 2 + (tid >> 7), b = u.pm >> 4, blk = u.pm & 15;
                kmean[(((size_t)b * 8 + head) * 16 + blk) * 128 + (tid & 127)] = ks[tid] * (1.f / 256.f); }
        }
    }
};
struct EpiMoeOut {
    static constexpr bool PERM = true;
    bf16_t* Y; const int* idx;
    __device__ __forceinline__ void operator()(const f32x4 (&acc)[2][2][4][2], const Unit& u, int wr, int wc, int fr, int fq) const {
        const int col0 = u.po * BM + wc * 32 + 8 * fq;
#pragma unroll
        for (int ai = 0; ai < 2; ++ai)
#pragma unroll
            for (int m = 0; m < 4; ++m) { const int rl = ai * HALF + wr * 64 + m * 16 + fr;
                if (rl < u.rows) { const int en = idx[u.e * ECAP + u.mt * 256 + rl]; bf16_t* rowp = Y + (size_t)((en & 1) * T_ + (en >> 1)) * D_ + col0;
#pragma unroll
                    for (int bj = 0; bj < 2; ++bj) { const f32x4 v0 = acc[ai][bj][m][0], v1 = acc[ai][bj][m][1];
                        u32x4 w; w.x = cvt_pk_bf16(v0[0], v0[1]); w.y = cvt_pk_bf16(v0[2], v0[3]); w.z = cvt_pk_bf16(v1[0], v1[1]); w.w = cvt_pk_bf16(v1[2], v1[3]);
                        *(u32x4*)(rowp + bj * HALF) = w; } } }
    }
};

typedef int v8i __attribute__((ext_vector_type(8)));
template <class Epi, class Sched, bool FP8 = false>
__device__ __forceinline__ void gemm_phase(LAS unsigned char* lds, const bf16_t* A, const bf16_t* Bt, const int K, const Sched& S, const Epi& E, const int sclW = 127, const int sclA = 127) {
    int tid = threadIdx.x; asm volatile("" : "+v"(tid)); const int wid = __builtin_amdgcn_readfirstlane(tid >> 6), lane = tid & 63, wr = wid >> 2, wc = wid & 3, fr = lane & 15, fq = lane >> 4;
    const int nt = K / BK;
    int R0, C0, R1, C1; stage_rc(tid * 16, R0, C0); stage_rc(tid * 16 + 8192, R1, C1);
    unsigned voffB[2];
    { const int Rb0 = Epi::PERM ? ((R0 & ~31) + perm32(R0 & 31)) : R0, Rb1 = Epi::PERM ? ((R1 & ~31) + perm32(R1 & 31)) : R1;
      voffB[0] = (unsigned)(Rb0 * K + C0) * 2u; voffB[1] = (unsigned)(Rb1 * K + C1) * 2u; }
    const size_t kstep = (size_t)(BK * 2);
    const size_t hstep = (size_t)HALF * K * 2;
    const size_t tstep = 2 * hstep;
    const unsigned ldsw = (unsigned)wid * 1024u;
    const int aoff = lds_byte(wr * 64 + fr, fq * 8), boff = lds_byte(wc * 32 + fr, fq * 8);
    const int aoff1 = aoff + 1024, boff1 = boff + 1024;
    const char* Ab = (const char*)A;
#define PG8_SA(b, h) (((b) * 2 + (h)) * HTB)
#define PG8_SB(b, h) ((4 + (b) * 2 + (h)) * HTB)
#define PG8_STAGE(bufoff, gbase, voff) do { _Pragma("unroll") for (int _i = 0; _i < 2; ++_i) \
        __builtin_amdgcn_global_load_lds((const unsigned*)((const char*)(gbase) + (voff)[_i]), (LAS unsigned*)(lds + (bufoff) + ldsw + _i * 8192), 16, 0, 0); } while (0)
#define PG8_STAGE_A(bufoff, kptr, o0, o1) do { \
        __builtin_amdgcn_global_load_lds((const unsigned*)((kptr) + (o0)), (LAS unsigned*)(lds + (bufoff) + ldsw), 16, 0, 0); \
        __builtin_amdgcn_global_load_lds((const unsigned*)((kptr) + (o1)), (LAS unsigned*)(lds + (bufoff) + ldsw + 8192), 16, 0, 0); } while (0)
#define PG8_LDA(dst, b, h) do { _Pragma("unroll") for (int m = 0; m < 4; ++m) _Pragma("unroll") for (int k = 0; k < 2; ++k) dst[m][k] = *(const LAS bf16x8*)(lds + PG8_SA(b, h) + (k ? aoff1 : aoff) + m * 2048); } while (0)
#define PG8_LDB(dst, b, h) do { _Pragma("unroll") for (int n = 0; n < 2; ++n) _Pragma("unroll") for (int k = 0; k < 2; ++k) dst[n][k] = *(const LAS bf16x8*)(lds + PG8_SB(b, h) + (k ? boff1 : boff) + n * 2048); } while (0)
#define PG8_CAT(x0, x1) (__builtin_shufflevector(__builtin_bit_cast(u32x4, x0), __builtin_bit_cast(u32x4, x1), 0, 1, 2, 3, 4, 5, 6, 7))
#define PG8_MMA(ai, bj, At, Bt_) do { __builtin_amdgcn_s_setprio(1); _Pragma("unroll") for (int m = 0; m < 4; ++m) _Pragma("unroll") for (int n = 0; n < 2; ++n) { \
        if constexpr (FP8) { const v8i b8_ = __builtin_bit_cast(v8i, PG8_CAT(Bt_[n][0], Bt_[n][1])), a8_ = __builtin_bit_cast(v8i, PG8_CAT(At[m][0], At[m][1])); \
            asm volatile("v_mfma_scale_f32_16x16x128_f8f6f4 %0, %1, %2, %0, %3, %4 op_sel_hi:[0,0,0]" : "+v"(acc[ai][bj][m][n]) : "v"(b8_), "v"(a8_), "v"(vsclW), "v"(vsclA)); } \
        else { _Pragma("unroll") for (int k = 0; k < 2; ++k) acc[ai][bj][m][n] = __builtin_amdgcn_mfma_f32_16x16x32_bf16(Bt_[n][k], At[m][k], acc[ai][bj][m][n], 0, 0, 0); } } \
        __builtin_amdgcn_s_setprio(0); } while (0)
#define PG8_WAIT_V(n) asm volatile("s_waitcnt vmcnt(" #n ")" ::: "memory")
#define PG8_WAIT_L(n) asm volatile("s_waitcnt lgkmcnt(" #n ")" ::: "memory")
#define PG8_BAR __builtin_amdgcn_s_barrier()
#define PG8_SCHED __builtin_amdgcn_sched_barrier(0)
#define PG8_OFFS(u_, o00, o01, o10, o11) do { const unsigned rb_ = (unsigned)K * 2u; \
        o00 = (unsigned)S.arow(u_, R0) * rb_ + (unsigned)C0 * 2u; o01 = (unsigned)S.arow(u_, R1) * rb_ + (unsigned)C1 * 2u; \
        o10 = (unsigned)S.arow(u_, HALF + R0) * rb_ + (unsigned)C0 * 2u; o11 = (unsigned)S.arow(u_, HALF + R1) * rb_ + (unsigned)C1 * 2u; } while (0)
    Unit cur, nxt; int ui = 0;
    if (!S.next(0, cur)) return;
    f32x4 acc[2][2][4][2];
#pragma unroll
    for (int a = 0; a < 2; ++a)
#pragma unroll
        for (int b = 0; b < 2; ++b)
#pragma unroll
            for (int m = 0; m < 4; ++m)
#pragma unroll
                for (int n = 0; n < 2; ++n) acc[a][b][m][n] = (f32x4){0.f, 0.f, 0.f, 0.f};
    bf16x8 At[4][2], B0[2][2], B1[2][2];
    int vsclW = sclW, vsclA = sclA; asm volatile("" : "+v"(vsclW), "+v"(vsclA));
    unsigned oC00, oC01, oC10, oC11, oN00, oN01, oN10, oN11;
    PG8_OFFS(cur, oC00, oC01, oC10, oC11);
    const char* cB = (const char*)Bt + (size_t)cur.pn * tstep;
    PG8_STAGE(PG8_SB(0, 0), cB, voffB); PG8_STAGE(PG8_SB(0, 1), cB + hstep, voffB); PG8_STAGE_A(PG8_SA(0, 0), Ab, oC00, oC01); PG8_STAGE_A(PG8_SA(0, 1), Ab, oC10, oC11);
    if (wr == 1) PG8_BAR;
    PG8_WAIT_V(2); PG8_BAR;
    PG8_STAGE(PG8_SB(1, 0), cB + kstep, voffB); PG8_STAGE_A(PG8_SA(1, 0), Ab + kstep, oC00, oC01); PG8_STAGE(PG8_SB(1, 1), cB + hstep + kstep, voffB);
    PG8_WAIT_V(6); PG8_BAR;
    for (;;) {
        const bool has_next = S.next(ui + 1, nxt);
        const char* nB = has_next ? (const char*)Bt + (size_t)nxt.pn * tstep : cB;
        if (has_next) { PG8_OFFS(nxt, oN00, oN01, oN10, oN11); } else { oN00 = oC00; oN01 = oC01; oN10 = oC10; oN11 = oC11; }
        for (int t = 0; t < nt; t += 2) {
            const bool last = (t == nt - 2);
            const char* a1 = Ab + (size_t)(t + 1) * kstep;
            const char* a2 = last ? Ab : Ab + (size_t)(t + 2) * kstep; const char* b2 = last ? nB : cB + (size_t)(t + 2) * kstep;
            const char* a3 = a2 + kstep; const char* b3 = b2 + kstep;
            const unsigned x00 = last ? oN00 : oC00, x01 = last ? oN01 : oC01, x10 = last ? oN10 : oC10, x11 = last ? oN11 : oC11;
            PG8_LDB(B0, 0, 0); PG8_LDB(B1, 0, 1); PG8_SCHED; PG8_LDA(At, 0, 0); PG8_STAGE_A(PG8_SA(1, 1), a1, oC10, oC11);
            PG8_WAIT_V(8); PG8_WAIT_L(0); PG8_BAR; PG8_MMA(0, 0, At, B0); PG8_MMA(0, 1, At, B1); PG8_BAR; PG8_SCHED;
            PG8_LDA(At, 0, 1); PG8_STAGE(PG8_SB(0, 0), b2, voffB); PG8_STAGE(PG8_SB(0, 1), b2 + hstep, voffB); PG8_STAGE_A(PG8_SA(0, 0), a2, x00, x01);
            PG8_WAIT_V(8); PG8_WAIT_L(0); PG8_BAR; PG8_MMA(1, 0, At, B0); PG8_MMA(1, 1, At, B1); PG8_BAR; PG8_SCHED;
            PG8_LDB(B0, 1, 0); PG8_LDB(B1, 1, 1); PG8_SCHED; PG8_LDA(At, 1, 0); PG8_STAGE_A(PG8_SA(0, 1), a2, x10, x11);
            PG8_WAIT_V(8); PG8_WAIT_L(0); PG8_BAR; PG8_MMA(0, 0, At, B0); PG8_MMA(0, 1, At, B1); PG8_BAR; PG8_SCHED;
            PG8_LDA(At, 1, 1); PG8_STAGE(PG8_SB(1, 0), b3, voffB); PG8_STAGE(PG8_SB(1, 1), b3 + hstep, voffB); PG8_STAGE_A(PG8_SA(1, 0), a3, x00, x01);
            PG8_WAIT_V(8); PG8_WAIT_L(0); PG8_BAR; PG8_MMA(1, 0, At, B0); PG8_MMA(1, 1, At, B1); PG8_BAR; PG8_SCHED;
        }
        if (wr == 0) PG8_BAR;
        if constexpr (FP8) asm volatile("s_nop 15\n\ts_nop 15" ::: "memory");
        E(acc, cur, wr, wc, fr, fq);
        if (!has_next) break;
#pragma unroll
        for (int a = 0; a < 2; ++a)
#pragma unroll
            for (int b = 0; b < 2; ++b)
#pragma unroll
                for (int m = 0; m < 4; ++m)
#pragma unroll
                    for (int n = 0; n < 2; ++n) acc[a][b][m][n] = (f32x4){0.f, 0.f, 0.f, 0.f};
        cur = nxt; cB = nB; oC00 = oN00; oC01 = oN01; oC10 = oN10; oC11 = oN11; ++ui;
        if (wr == 1) PG8_BAR;
    }
    PG8_WAIT_V(0);
    PG8_BAR;
#undef PG8_SA
#undef PG8_SB
#undef PG8_STAGE
#undef PG8_STAGE_A
#undef PG8_LDA
#undef PG8_LDB
#undef PG8_MMA
#undef PG8_CAT
#undef PG8_WAIT_V
#undef PG8_WAIT_L
#undef PG8_BAR
#undef PG8_SCHED
#undef PG8_OFFS
}

constexpr size_t MiB = 1u << 20;
constexpr size_t WS_CTL = 0, CTL_ZERO_BYTES = 1 * MiB;
constexpr int CW_CNT = 1024;
constexpr int CW_BAR = 4096;
constexpr size_t WS_IDX = 1 * MiB;
constexpr size_t WS_GATE = WS_IDX + 512 * 1024;
constexpr size_t WS_ZS = 2 * MiB;
constexpr size_t WS_WIN = 3 * MiB;
constexpr size_t WS_WOUT0 = WS_WIN + (size_t)3584 * 1024 * 2;
constexpr size_t WS_WGU = WS_WOUT0 + (size_t)1024 * 1024 * 2;
constexpr size_t WS_WDN = WS_WGU + (size_t)5632 * 1024 * 2;
constexpr size_t WS_WQKV = WS_WDN + (size_t)1024 * 2816 * 2;
constexpr size_t WS_WOUT1 = WS_WQKV + (size_t)3072 * 1024 * 2;
constexpr size_t WS_W1E = WS_WOUT1 + (size_t)1024 * 1024 * 2;
constexpr size_t WS_W2E = WS_W1E + (size_t)8 * 7168 * 1024 * 2;
constexpr size_t WS_WEND = WS_W2E + (size_t)8 * 1024 * 3584 * 2;
constexpr size_t WS_HN = (WS_WEND + MiB - 1) / MiB * MiB;
constexpr size_t WS_MIXB = WS_HN + 32 * MiB;
constexpr size_t WS_HA = WS_MIXB + 32 * MiB;
constexpr size_t WS_FNEG = WS_HA + 64 * MiB;
constexpr size_t WS_KMEAN = WS_FNEG + 512 * 1024;
constexpr size_t WS_ROPE = WS_KMEAN + 256 * 1024;
constexpr size_t WS_ZB = WS_ROPE + 3 * MiB - 512 * 1024;
constexpr size_t WS_GDN = WS_ZB + 120 * MiB;
constexpr size_t WS_YBUF = WS_ZB + 256 * MiB;
constexpr size_t WS_FASTEND = WS_ZB + 320 * MiB;

constexpr int RING_BYTES = 131072, LDS_BYTES = 147456, MISC_OFF = LDS_BYTES - 256;

struct Args { const float* in[23]; float* out; unsigned char* ws; int ph_lo, ph_hi; };

__device__ __forceinline__ void transpose_item(const float* W, int ldw, int K, int srccol0, bf16_t* WT, int dstrow0, int k0, LAS float* scr, int lane) {
    { float tv[32]; const float* wp = W + (size_t)(k0 + (lane >> 5)) * ldw + srccol0 + (lane & 31);
#pragma unroll
      for (int i = 0; i < 32; ++i) tv[i] = wp[(size_t)(2 * i) * ldw];
#pragma unroll
      for (int i = 0; i < 32; ++i) scr[(2 * i + (lane >> 5)) * 33 + (lane & 31)] = tv[i]; }
    asm volatile("s_waitcnt lgkmcnt(0)" ::: "memory");
    const int c = lane & 7;
#pragma unroll
    for (int j = 0; j < 4; ++j) { const int n = (lane >> 3) + 8 * j; const LAS float* s = scr + (8 * c) * 33 + n;
        u32x4 o; o.x = cvt_pk_bf16(s[0 * 33], s[1 * 33]); o.y = cvt_pk_bf16(s[2 * 33], s[3 * 33]); o.z = cvt_pk_bf16(s[4 * 33], s[5 * 33]); o.w = cvt_pk_bf16(s[6 * 33], s[7 * 33]);
        *(u32x4*)(WT + (size_t)(dstrow0 + n) * K + k0 + 8 * c) = o; }
    asm volatile("s_waitcnt lgkmcnt(0)" ::: "memory");
}
__device__ __forceinline__ void transpose_item8(const float* W, int ldw, int K, int srccol0, unsigned char* WT, int dstrow0, int k0, LAS float* scr, int lane, float wscale) {
    { float tv[64]; const float* wp = W + (size_t)(k0 + (lane >> 5)) * ldw + srccol0 + (lane & 31);
#pragma unroll
      for (int i = 0; i < 64; ++i) tv[i] = wp[(size_t)(2 * i) * ldw];
#pragma unroll
      for (int i = 0; i < 64; ++i) scr[(2 * i + (lane >> 5)) * 33 + (lane & 31)] = tv[i]; }
    asm volatile("s_waitcnt lgkmcnt(0)" ::: "memory");
    const int n = lane >> 1, hf = lane & 1; const LAS float* s = scr + (64 * hf) * 33 + n;
    unsigned char* d = WT + (size_t)(dstrow0 + n) * K + k0 + 64 * hf;
#pragma unroll
    for (int q = 0; q < 4; ++q) { u32x4 o;
        o.x = pk4_fp8(s[(16 * q + 0) * 33] * wscale, s[(16 * q + 1) * 33] * wscale, s[(16 * q + 2) * 33] * wscale, s[(16 * q + 3) * 33] * wscale);
        o.y = pk4_fp8(s[(16 * q + 4) * 33] * wscale, s[(16 * q + 5) * 33] * wscale, s[(16 * q + 6) * 33] * wscale, s[(16 * q + 7) * 33] * wscale);
        o.z = pk4_fp8(s[(16 * q + 8) * 33] * wscale, s[(16 * q + 9) * 33] * wscale, s[(16 * q + 10) * 33] * wscale, s[(16 * q + 11) * 33] * wscale);
        o.w = pk4_fp8(s[(16 * q + 12) * 33] * wscale, s[(16 * q + 13) * 33] * wscale, s[(16 * q + 14) * 33] * wscale, s[(16 * q + 15) * 33] * wscale);
        *(u32x4*)(d + 16 * q) = o; }
    asm volatile("s_waitcnt lgkmcnt(0)" ::: "memory");
}
struct TwItem { const float* src; unsigned char* dst; int ldw, dp; };
template <bool FP8> __device__ __forceinline__ void tw_load(f32x4 (&v)[16], const TwItem& t) {
    constexpr int RW = FP8 ? 16 : 8;
#pragma unroll
    for (int i = 0; i < RW; ++i) v[i] = *(const f32x4*)(t.src + (size_t)i * t.ldw);
}
template <bool FP8> __device__ __forceinline__ void tw_store(const f32x4 (&v)[16], const TwItem& t, LAS unsigned char* buf, int tid, int lane, int wave, float ws_) {
#pragma unroll
    for (int c = 0; c < 4; ++c) { u32x4 o;
        if (FP8) { o.x = pk4_fp8(v[0][c] * ws_, v[1][c] * ws_, v[2][c] * ws_, v[3][c] * ws_); o.y = pk4_fp8(v[4][c] * ws_, v[5][c] * ws_, v[6][c] * ws_, v[7][c] * ws_);
                   o.z = pk4_fp8(v[8][c] * ws_, v[9][c] * ws_, v[10][c] * ws_, v[11][c] * ws_); o.w = pk4_fp8(v[12][c] * ws_, v[13][c] * ws_, v[14][c] * ws_, v[15][c] * ws_); }
        else { o.x = cvt_pk_bf16(v[0][c], v[1][c]); o.y = cvt_pk_bf16(v[2][c], v[3][c]); o.z = cvt_pk_bf16(v[4][c], v[5][c]); o.w = cvt_pk_bf16(v[6][c], v[7][c]); }
        *(LAS u32x4*)(buf + (4 * lane + c) * 144 + 16 * wave) = o; }
    asm volatile("s_waitcnt lgkmcnt(0)\n\ts_barrier" ::: "memory");
#pragma unroll
    for (int q = 0; q < 4; ++q) { const int ix = tid + 512 * q, n = ix >> 3, sg = ix & 7; const u32x4 o = *(const LAS u32x4*)(buf + n * 144 + 16 * sg); *(u32x4*)(t.dst + (size_t)n * t.dp + 16 * sg) = o; }
}
#define TW_LOOP(FP8_, FIRST_, END_, STRIDE_, DECODE_, SCALE_) do { \
    f32x4 va_[16], vb_[16]; TwItem ta_, tb_; int it_ = (FIRST_); \
    asm volatile("s_waitcnt lgkmcnt(0)\n\ts_barrier" ::: "memory");     \
    if (it_ < (END_)) { ta_ = DECODE_(it_); tw_load<FP8_>(va_, ta_); int last_ = 0; \
        while (true) {     \
            if (!(it_ + (STRIDE_) < (END_))) { last_ = 0; break; } \
            it_ += (STRIDE_); tb_ = DECODE_(it_); tw_load<FP8_>(vb_, tb_); tw_store<FP8_>(va_, ta_, lds, tid, lane, wave, SCALE_); \
            if (!(it_ + (STRIDE_) < (END_))) { last_ = 1; break; } \
            it_ += (STRIDE_); ta_ = DECODE_(it_); tw_load<FP8_>(va_, ta_); tw_store<FP8_>(vb_, tb_, lds + 36864, tid, lane, wave, SCALE_); } \
        if (last_ == 0) tw_store<FP8_>(va_, ta_, lds, tid, lane, wave, SCALE_); else tw_store<FP8_>(vb_, tb_, lds + 36864, tid, lane, wave, SCALE_); } } while (0)
__device__ __forceinline__ int map_inproj(int n) { const int g = n >> 9, r = n & 511; const int off = g == 0 ? 0 : g == 1 ? 512 : g == 2 ? 1024 : g == 3 ? 1540 : g == 4 ? 2052 : g == 5 ? 2564 : 3084; return off + r; }
__device__ __forceinline__ int map_qkv(int n) { if (n >= 2048) return n; const int t = n >> 8, r = n & 255, half = r >> 7, w = r & 127; return t * 256 + (w >> 6) * 128 + (w & 63) + 64 * half; }
__device__ __forceinline__ int map_gu(int n, int F) { const int j = n >> 8, r = n & 255; return r < 128 ? j * 128 + r : F + j * 128 + (r - 128); }

__device__ __forceinline__ TwItem tw_expert(int I, const float* w_e1, const float* w_e2, unsigned char* W1, unsigned char* W2, int lane, int wave) {
    TwItem t; int r = I; constexpr int J1 = 8 * 28, J2 = 28 * 4;
    if (r < 8 * J1) { const int e = r / J1, q = r % J1, kb = q / 28, j = q % 28;
        t.src = w_e1 + (size_t)e * 1024 * 7168 + (size_t)(128 * kb + 16 * wave) * 7168 + map_gu(256 * j + 4 * lane, 3584); t.ldw = 7168;
        t.dst = W1 + (size_t)e * 7168 * 1024 + (size_t)(256 * j) * 1024 + 128 * kb; t.dp = 1024; }
    else { r -= 8 * J1; const int e = r / J2, q = r % J2, kb = q >> 2, j = q & 3;
        t.src = w_e2 + (size_t)e * 3584 * 1024 + (size_t)(128 * kb + 16 * wave) * 1024 + 256 * j + 4 * lane; t.ldw = 1024;
        t.dst = W2 + (size_t)e * 1024 * 3584 + (size_t)(256 * j) * 3584 + 128 * kb; t.dp = 3584; }
    return t;
}
__device__ __forceinline__ void rms_row(const float* xrow, const float* gain, bf16_t* orow, int lane, f32x4 (&v)[4]) {
    const f32x4* xr = (const f32x4*)xrow + lane; const f32x4* gr = (const f32x4*)gain + lane;
    float s = 0.f;
#pragma unroll
    for (int j = 0; j < 4; ++j) { v[j] = xr[64 * j]; s += (v[j].x * v[j].x + v[j].y * v[j].y) + (v[j].z * v[j].z + v[j].w * v[j].w); }
    const float r = rsqrtf(wave_sum(s) * (1.f / 1024.f) + 1e-6f);
    u32x2* o8 = (u32x2*)orow + lane;
#pragma unroll
    for (int j = 0; j < 4; ++j) { const f32x4 g = gr[64 * j]; v[j] = v[j] * r * g; u32x2 w; w.x = cvt_pk_bf16(v[j].x, v[j].y); w.y = cvt_pk_bf16(v[j].z, v[j].w); o8[64 * j] = w; }
}

template <int NR, bool FP8, bool IN_BF16 = false> __device__ __forceinline__ void rms_rows(const void* x, const float* gain, void* out, int m0, int mstep, int lane, f32x4 (&v)[NR][4]) {
#pragma unroll
    for (int r = 0; r < NR; ++r) {
        if (IN_BF16) { const u32x2* xr = (const u32x2*)((const bf16_t*)x + (size_t)(m0 + r * mstep) * D_) + lane; u32x2 t[4];
#pragma unroll
            for (int j = 0; j < 4; ++j) t[j] = xr[64 * j];
#pragma unroll
            for (int j = 0; j < 4; ++j) { v[r][j].x = __uint_as_float(t[j].x << 16); v[r][j].y = __uint_as_float(t[j].x & 0xffff0000u); v[r][j].z = __uint_as_float(t[j].y << 16); v[r][j].w = __uint_as_float(t[j].y & 0xffff0000u); } }
        else { const f32x4* xr = (const f32x4*)((const float*)x + (size_t)(m0 + r * mstep) * D_) + lane;
#pragma unroll
            for (int j = 0; j < 4; ++j) v[r][j] = xr[64 * j]; } }
    f32x4 g[4]; { const f32x4* gr = (const f32x4*)gain + lane;
#pragma unroll
        for (int j = 0; j < 4; ++j) g[j] = gr[64 * j]; }
#pragma unroll
    for (int r = 0; r < NR; ++r) { float s = 0.f;
#pragma unroll
        for (int j = 0; j < 4; ++j) s += (v[r][j].x * v[r][j].x + v[r][j].y * v[r][j].y) + (v[r][j].z * v[r][j].z + v[r][j].w * v[r][j].w);
        const float rs = rsqrtf(wave_sum(s) * (1.f / 1024.f) + 1e-6f);
        const size_t m = (size_t)(m0 + r * mstep);
#pragma unroll
        for (int j = 0; j < 4; ++j) { v[r][j] = v[r][j] * rs * g[j];
            if (FP8) ((unsigned*)((unsigned char*)out + m * D_) + lane)[64 * j] = pk4_fp8(v[r][j].x, v[r][j].y, v[r][j].z, v[r][j].w);
            else { u32x2 w; w.x = cvt_pk_bf16(v[r][j].x, v[r][j].y); w.y = cvt_pk_bf16(v[r][j].z, v[r][j].w); ((u32x2*)((bf16_t*)out + m * D_) + lane)[64 * j] = w; } } }
}
#define XB_TMO      128
#define XB_XCNT(j)  (256  + 64 * (j))
#define XB_XSUB(j)  (1280 + 64 * (j))
#define XB_XGEN(j)  (2304 + 64 * (j))
#define XB_TOP      3328
#define XB_TOPGEN   3392
#define XCD_BAR_WORDS 3456
#define XB_SPIN_CAP (1u << 18)

__device__ __forceinline__ unsigned xb_ld(unsigned* p)              { return __hip_atomic_load(p, __ATOMIC_RELAXED, __HIP_MEMORY_SCOPE_AGENT); }
__device__ __forceinline__ unsigned xb_add(unsigned* p, unsigned v) { return __hip_atomic_fetch_add(p, v, __ATOMIC_RELAXED, __HIP_MEMORY_SCOPE_AGENT); }
__device__ __forceinline__ unsigned xb_xcc_id() { return (unsigned)__builtin_amdgcn_s_getreg((3 << 11) | 20) & 0xFu; }
#define XB_SPIN(cond, bar) do { unsigned _sp = 0; while (cond) { __builtin_amdgcn_s_sleep(1); \
    if ((++_sp & 255u) == 0u) { if (xb_ld(&(bar)[XB_TMO])) break; if (_sp > XB_SPIN_CAP) { atomicAdd(&(bar)[XB_TMO], 1u); break; } } } } while (0)

struct XcdBarrier {
    unsigned* bar; unsigned x;
    volatile LAS unsigned* st;
};

__device__ __forceinline__ XcdBarrier xcd_barrier_post(unsigned* bar, volatile LAS unsigned* st) {
    XcdBarrier b; b.bar = bar; b.x = xb_xcc_id(); b.st = st;
    if (threadIdx.x == 0) (void)xb_add(&bar[XB_XCNT(b.x)], 1u);
    return b;
}
__device__ __forceinline__ void xcd_barrier_complete(unsigned* bar, unsigned x, unsigned& nloc, unsigned& nx) {
    const unsigned G = gridDim.x * gridDim.y * gridDim.z;
    unsigned sum, cnt, mine, sp = 0u;
    for (;;) {
        sum = 0u; cnt = 0u; mine = 0u;
#pragma unroll
        for (unsigned j = 0; j < 16; ++j) { const unsigned c = xb_ld(&bar[XB_XCNT(j)]); sum += c; cnt += (c > 0u) ? 1u : 0u; mine = (j == x) ? c : mine; }
        if (sum == G) break;
        __builtin_amdgcn_s_sleep(1);
        if ((++sp & 255u) == 0u) { if (xb_ld(&bar[XB_TMO])) break; if (sp > XB_SPIN_CAP) { atomicAdd(&bar[XB_TMO], 1u); break; } }
    }
    nloc = mine > 0u ? mine : 1u; nx = cnt > 0u ? cnt : 1u;
}

__device__ __forceinline__ void xcd_barrier(const XcdBarrier& b) {
    asm volatile("s_waitcnt vmcnt(0)" ::: "memory");
    __syncthreads();
    if (threadIdx.x == 0) {
        unsigned* bar = b.bar;
        __builtin_amdgcn_s_waitcnt(0);
        unsigned nloc = b.st[0], nx = b.st[1];
        if (nloc == 0u) { xcd_barrier_complete(bar, b.x, nloc, nx); b.st[0] = nloc; b.st[1] = nx; }
        const unsigned old = xb_add(&bar[XB_XSUB(b.x)], 1u);
        const unsigned gen = old / nloc;
        if (old + 1u == (gen + 1u) * nloc) {
            __builtin_amdgcn_fence(__ATOMIC_RELEASE, "agent");
            asm volatile("s_waitcnt vmcnt(0)" ::: "memory");
            const unsigned og = xb_add(&bar[XB_TOP], 1u);
            const unsigned tg = og / nx;
            if (og + 1u == (tg + 1u) * nx) xb_add(&bar[XB_TOPGEN], 1u);
            else XB_SPIN(xb_ld(&bar[XB_TOPGEN]) == tg, bar);
            __builtin_amdgcn_fence(__ATOMIC_ACQUIRE, "agent");
            xb_add(&bar[XB_XGEN(b.x)], 1u);
            asm volatile("s_waitcnt vmcnt(0)" ::: "memory");
        } else {
            XB_SPIN(xb_ld(&bar[XB_XGEN(b.x)]) == gen, bar);
            __builtin_amdgcn_fence(__ATOMIC_ACQUIRE, "agent");
            asm volatile("s_waitcnt vmcnt(0)" ::: "memory");
        }
    }
    __syncthreads();
}


__device__ __forceinline__ void rms_row8(const float* xrow, const float* gain, unsigned char* orow, int lane, f32x4 (&v)[4]) {
    const f32x4* xr = (const f32x4*)xrow + lane; const f32x4* gr = (const f32x4*)gain + lane;
    float s = 0.f;
#pragma unroll
    for (int j = 0; j < 4; ++j) { v[j] = xr[64 * j]; s += (v[j].x * v[j].x + v[j].y * v[j].y) + (v[j].z * v[j].z + v[j].w * v[j].w); }
    const float r = rsqrtf(wave_sum(s) * (1.f / 1024.f) + 1e-6f);
    unsigned* o4 = (unsigned*)orow + lane;
#pragma unroll
    for (int j = 0; j < 4; ++j) { const f32x4 g = gr[64 * j]; v[j] = v[j] * r * g; o4[64 * j] = pk4_fp8(v[j].x, v[j].y, v[j].z, v[j].w); }
}
 constexpr int TAIL_TAB[12] = {11,11,11,11,11,11,11,11,3,4,5,7};
 constexpr int GU_R = 7;
__host__ __device__ constexpr int tail_rounds(int n) { return TAIL_TAB[n]; }
__host__ __device__ constexpr int tail_prev(int n) { int p = 0; for (int i = 0; i < n; ++i) p += tail_rounds(i); return p; }
constexpr int N_EXPERT_ITEMS = 8 * 8 * 224 + 8 * 28 * 32, NT_TAIL = 8 * 16 * tail_prev(12);
static_assert(NT_TAIL / 8 + 128 * GU_R <= N_EXPERT_ITEMS / 8, "expert items over-assigned");
enum Phase { PH_PRO = 0, PH_INPROJ = 1, PH_FOXPREP = 2, PH_ATTN0 = 3, PH_GDN3 = 4, PH_OUT0 = 5, PH_NORM2 = 6, PH_GU = 7, PH_DN = 8, PH_NORM3 = 9, PH_QKV = 10, PH_MOBAPREP = 11, PH_ATTN1 = 12, PH_OUT1 = 13, PH_ROUTE = 14, PH_MOE1 = 15, PH_MOE2 = 16, PH_COMB = 17, PH_END = 18 };

__device__ __forceinline__ unsigned long long karg64(int byte_off) { unsigned long long v; const unsigned long long kp = (unsigned long long)__builtin_amdgcn_kernarg_segment_ptr();
    asm volatile("s_load_dwordx2 %0, %1, %2\n\ts_waitcnt lgkmcnt(0)" : "=s"(v) : "s"(kp), "s"(byte_off)); return v; }
#define ARG_IN(i) ((const float*)(const GAS float*)karg64(8 * (i)))
#define ARG_OUT ((float*)(GAS float*)karg64(184))
 constexpr int KN[4] = {1,1,1,1};
 constexpr int REPS[20] = {1,1,1,1,1,1,1,1,1,1,1,1,1,1,1,1,1,1,1,1};
__global__ void __launch_bounds__(512, 2) mk_fwd(Args args) {
    extern __shared__ __attribute__((aligned(16))) unsigned char lds_raw[];
    LAS unsigned char* lds = (LAS unsigned char*)lds_raw;
    const int G = gridDim.x, bx = blockIdx.x, NGW = G * NWAVES;
#define PH_IDS() int tid = threadIdx.x; asm volatile("" : "+v"(tid)); const int lane = tid & 63, wave = __builtin_amdgcn_readfirstlane(tid >> 6); const int gw = bx * NWAVES + wave; (void)lane; (void)gw
#define ws (args.ws)
#define ctl ((unsigned*)(ws + WS_CTL))
#define cnt ((int*)(ctl + CW_CNT))
#define idx ((int*)(ws + WS_IDX))
#define gate ((float*)(ws + WS_GATE))
#define zs ((float*)(ws + WS_ZS))
#define Win ((bf16_t*)(ws + WS_WIN))
#define Wout0 ((bf16_t*)(ws + WS_WOUT0))
#define Wgu ((bf16_t*)(ws + WS_WGU))
#define Wdn ((bf16_t*)(ws + WS_WDN))
#define Wqkv ((bf16_t*)(ws + WS_WQKV))
#define Wout1 ((bf16_t*)(ws + WS_WOUT1))
#define W1e ((bf16_t*)(ws + WS_W1E))
#define W2e ((bf16_t*)(ws + WS_W2E))
#define hn ((bf16_t*)(ws + WS_HN))
#define mixb ((bf16_t*)(ws + WS_MIXB))
#define hA ((bf16_t*)(ws + WS_HA))
#define hB ((bf16_t*)(ws + WS_HA + 32 * MiB))
#define zb ((bf16_t*)(ws + WS_ZB))
#define ybuf ((bf16_t*)(ws + WS_YBUF))
#define fneg ((float*)(ws + WS_FNEG))
#define kmean ((float*)(ws + WS_KMEAN))
#define ropec ((float*)(ws + WS_ROPE))
#define ropes (ropec + 4096 * 64)
#define GBUFS() gd::GdnBufs gbufs; gbufs.T = (bf16_t*)(ws + WS_GDN); gbufs.RT = (float*)(ws + WS_GDN + 32 * MiB); gbufs.ST = (bf16_t*)(ws + WS_GDN + 96 * MiB); gbufs.QT = (bf16_t*)(ws + WS_GDN + 128 * MiB); gbufs.OL = (float*)(ws + WS_GDN + 144 * MiB)
    const int lo = args.ph_lo, hi = args.ph_hi;
#define IN(k) (lo <= (k) && (k) < hi)
    volatile LAS unsigned* MISC = (volatile LAS unsigned*)(lds + MISC_OFF);
    if (threadIdx.x < 64) MISC[threadIdx.x] = 0u;
    __syncthreads();
    XcdBarrier bar; bar.bar = ctl + CW_BAR; bar.x = 0; bar.st = MISC + 8;
    if (hi - lo > 1) bar = xcd_barrier_post(ctl + CW_BAR, MISC + 8);
#define SEAM(k) do { if (IN(k) && IN((k) + 1)) xcd_barrier(bar); } while (0)

    if (IN(PH_PRO)) for (int rep_ = 0; rep_ < REPS[PH_PRO]; ++rep_) { if (rep_) xcd_barrier(bar); PH_IDS();
        const float* w_in = ARG_IN(2); const float* w_out0 = ARG_IN(10); const float* w_e1 = ARG_IN(21); const float* w_e2 = ARG_IN(22);
        auto dec_d0 = [&](int I) -> TwItem { TwItem t;
            if (I < 224) { const int kb = I / 14, j = I % 14; t.src = w_in + (size_t)(64 * kb + 8 * wave) * 3596 + map_inproj(256 * j + 4 * lane); t.ldw = 3596; t.dst = (unsigned char*)Win + (size_t)(256 * j) * 2048 + 128 * kb; t.dp = 2048; }
            else { const int r = I - 224, kb = r >> 2, j = r & 3; t.src = w_out0 + (size_t)(64 * kb + 8 * wave) * 1024 + 256 * j + 4 * lane; t.ldw = 1024; t.dst = (unsigned char*)Wout0 + (size_t)(256 * j) * 2048 + 128 * kb; t.dp = 2048; }
            return t; };
        auto dec_ex = [&](int I) -> TwItem { return tw_expert(I, w_e1, w_e2, (unsigned char*)W1e, (unsigned char*)W2e, lane, wave); };
        for (int k_ = 0; k_ < KN[0]; ++k_) { TW_LOOP(false, bx, 288, G, dec_d0, 1.f);
        TW_LOOP(true, NT_TAIL / 8 + 128 * GU_R + bx, N_EXPERT_ITEMS / 8, G, dec_ex, 64.f); __syncthreads(); }
        __syncthreads();
        LAS float* wsm = (LAS float*)lds;
        for (int i = tid; i < 3 * 1024; i += 512) { const int k = i & 1023, c = i >> 10; const f32x4 w4 = *(const f32x4*)(w_in + (size_t)k * 3596 + (c == 0 ? 1536 : 3072 + 4 * c));
            wsm[(4 * c + 0) * 1024 + k] = w4.x; wsm[(4 * c + 1) * 1024 + k] = w4.y; wsm[(4 * c + 2) * 1024 + k] = w4.z; wsm[(4 * c + 3) * 1024 + k] = w4.w; }
        __syncthreads();
        const float* x_in = ARG_IN(0); const float* g_in = ARG_IN(1);
        for (int k_ = 0; k_ < KN[1]; ++k_) for (int m = gw; m < T_; m += 8 * NGW) {
            f32x4 v[8][4]; rms_rows<8, false>(x_in, g_in, hn, m, NGW, lane, v);
#pragma unroll
            for (int j = 0; j < 12; ++j) { f32x2 a[8];
#pragma unroll
                for (int r = 0; r < 8; ++r) a[r] = (f32x2){0.f, 0.f};
#pragma unroll
                for (int q = 0; q < 4; ++q) { const f32x4 w4 = *(const LAS f32x4*)(wsm + j * 1024 + 256 * q + 4 * lane);
#pragma unroll
                    for (int r = 0; r < 8; ++r) { a[r] += v[r][q].xy * w4.xy; a[r] += v[r][q].zw * w4.zw; } }
#pragma unroll
                for (int r = 0; r < 8; ++r) { const float d = wave_sum(a[r].x + a[r].y); if (lane == 0) zs[(size_t)(m + r * NGW) * 12 + j] = d; } }
        }
        for (int i = bx * 512 + tid; i < 4096 * 64; i += G * 512) { const int pos = i >> 6, j = i & 63; const float inv = exp2f(-(float)j * (13.287712379549449f / 64.f)); float sn, cs; sincosf((float)pos * inv, &sn, &cs); ropec[i] = cs; ropes[i] = sn; }
        __syncthreads();
    }
    SEAM(PH_PRO);
    if (IN(PH_INPROJ)) for (int rep_ = 0; rep_ < REPS[PH_INPROJ]; ++rep_) { if (rep_) xcd_barrier(bar); DenseOrder S; S.init(T_, 3584, G, bx); EpiBf16 E{zb, 3584}; gemm_phase(lds, hn, Win, 1024, S, E);
        if (bx >= 128 && G == 256 && rep_ == 0) {
            PH_IDS(); __syncthreads();
            const float* w_gu = ARG_IN(12); const float* w_dn = ARG_IN(13); const float* w_qkv = ARG_IN(15); const float* w_out1 = ARG_IN(18);
            auto dec_d1 = [&](int I) -> TwItem { TwItem t;
                if (I < 352) { const int kb = I / 22, j = I % 22; t.src = w_gu + (size_t)(64 * kb + 8 * wave) * 5632 + map_gu(256 * j + 4 * lane, 2816); t.ldw = 5632; t.dst = (unsigned char*)Wgu + (size_t)(256 * j) * 2048 + 128 * kb; t.dp = 2048; }
                else { const int r = I - 352, kb = r >> 2, j = r & 3; t.src = w_out1 + (size_t)(64 * kb + 8 * wave) * 1024 + 256 * j + 4 * lane; t.ldw = 1024; t.dst = (unsigned char*)Wout1 + (size_t)(256 * j) * 2048 + 128 * kb; t.dp = 2048; }
                return t; };
            auto dec_q = [&](int I) -> TwItem { TwItem t;
                if (I < 96) { const int kb = I / 12, j = I % 12; t.src = w_qkv + (size_t)(128 * kb + 16 * wave) * 3072 + map_qkv(256 * j + 4 * lane); t.ldw = 3072; t.dst = (unsigned char*)Wqkv + (size_t)(256 * j) * 1024 + 128 * kb; t.dp = 1024; }
                else { const int r = I - 96, kb = r >> 2, j = r & 3; t.src = w_dn + (size_t)(128 * kb + 16 * wave) * 1024 + 256 * j + 4 * lane; t.ldw = 1024; t.dst = (unsigned char*)Wdn + (size_t)(256 * j) * 2816 + 128 * kb; t.dp = 2816; }
                return t; };
            TW_LOOP(false, (bx < 240 ? bx - 128 : (1 << 30)), 416, 112, dec_d1, 1.f);
            TW_LOOP(true, (bx < 240 ? bx - 128 : (1 << 30)), 184, 112, dec_q, 64.f);
            if (bx >= 240) {
                const int bh = bx - 240, q = wave, b = bh >> 2, h = bh & 3; const float fb = ARG_IN(3)[h]; const float* qg = ARG_IN(4); const float* kg = ARG_IN(5);
                float* fr_ = fneg + (size_t)bh * 4160 + q * 512 + lane * 8; LAS float* tl_ = (LAS float*)(lds + 73728);
                float tot = 0.f, ls_[8];
#pragma unroll
                for (int i = 0; i < 8; ++i) { const float xv = zs[(size_t)(b * 4096 + q * 512 + lane * 8 + i) * 12 + h] + fb; ls_[i] = xv > 0.f ? -log1pf(expf(-xv)) : xv - log1pf(expf(xv)); tot += ls_[i]; }
                float inc = tot;
#pragma unroll
                for (int o = 1; o < 64; o <<= 1) { const float t = __shfl_up(inc, o); if (lane >= o) inc += t; }
                if (lane == 63) tl_[wave] = inc;
                __syncthreads();
                float run = inc - tot; for (int j = 0; j < q; ++j) run += tl_[j];
                f32x4 o0, o1; run += ls_[0]; o0.x = -run * 11.313708498984761f; run += ls_[1]; o0.y = -run * 11.313708498984761f; run += ls_[2]; o0.z = -run * 11.313708498984761f; run += ls_[3]; o0.w = -run * 11.313708498984761f;
                run += ls_[4]; o1.x = -run * 11.313708498984761f; run += ls_[5]; o1.y = -run * 11.313708498984761f; run += ls_[6]; o1.z = -run * 11.313708498984761f; run += ls_[7]; o1.w = -run * 11.313708498984761f;
                *(f32x4*)fr_ = o0; *(f32x4*)(fr_ + 4) = o1;
                if (q == 0) { float mq = fmaxf(fabsf(qg[lane]), fabsf(qg[lane + 64])), mk = fmaxf(fabsf(kg[lane]), fabsf(kg[lane + 64]));
                    for (int o = 32; o >= 1; o >>= 1) { mq = fmaxf(mq, __shfl_xor(mq, o)); mk = fmaxf(mk, __shfl_xor(mk, o)); }
                    if (lane == 0) fneg[(size_t)bh * 4160 + 4096] = (104.f + 2.f * 128.f * 0.08838834764831845f * mq * mk) * 11.313708498984761f; }
            }
            __syncthreads();
        }
    }

    SEAM(PH_INPROJ);
    if (IN(PH_FOXPREP)) { PH_IDS();
        const float* qg = ARG_IN(4); const float* kg = ARG_IN(5);
        const int dcol = (lane & 15) * 8;
        float gq[8], gk[8];
#pragma unroll
        for (int e = 0; e < 8; ++e) { gq[e] = qg[dcol + e]; gk[e] = kg[dcol + e]; }
        for (int m = gw; m < T_; m += NGW) {
#pragma unroll
            for (int part = 0; part < 2; ++part) {
                bf16_t* p = zb + (size_t)m * 3584 + part * 512 + lane * 8;
                const u32x4 raw = *(const u32x4*)p; float x[8];
                x[0] = __uint_as_float(raw.x << 16); x[1] = __uint_as_float(raw.x & 0xffff0000u); x[2] = __uint_as_float(raw.y << 16); x[3] = __uint_as_float(raw.y & 0xffff0000u);
                x[4] = __uint_as_float(raw.z << 16); x[5] = __uint_as_float(raw.z & 0xffff0000u); x[6] = __uint_as_float(raw.w << 16); x[7] = __uint_as_float(raw.w & 0xffff0000u);
                float ss = 0.f;
#pragma unroll
                for (int e = 0; e < 8; ++e) ss += x[e] * x[e];
                ss += __shfl_xor(ss, 1); ss += __shfl_xor(ss, 2); ss += __shfl_xor(ss, 4); ss += __shfl_xor(ss, 8);
                const float r = rsqrtf(ss * (1.f / 128.f) + 1e-6f);
#pragma unroll
                for (int e = 0; e < 8; ++e) x[e] = x[e] * r * (part ? gk[e] : gq[e]);
                u32x4 w; w.x = cvt_pk_bf16(x[0], x[1]); w.y = cvt_pk_bf16(x[2], x[3]); w.z = cvt_pk_bf16(x[4], x[5]); w.w = cvt_pk_bf16(x[6], x[7]);
                *(u32x4*)p = w;
            }
        }
        if (G != 256 && gw < 16) {
            const int b = gw >> 2, h = gw & 3; const float fb = ARG_IN(3)[h];
            float tot = 0.f;
            for (int i = 0; i < 64; ++i) { const float xv = zs[(size_t)(b * 4096 + lane * 64 + i) * 12 + h] + fb; tot += xv > 0.f ? -log1pf(expf(-xv)) : xv - log1pf(expf(xv)); }
            float inc = tot;
#pragma unroll
            for (int o = 1; o < 64; o <<= 1) { const float t = __shfl_up(inc, o); if (lane >= o) inc += t; }
            float run = inc - tot;
            for (int i = 0; i < 64; ++i) { const float xv = zs[(size_t)(b * 4096 + lane * 64 + i) * 12 + h] + fb; run += xv > 0.f ? -log1pf(expf(-xv)) : xv - log1pf(expf(xv)); fneg[(size_t)gw * 4160 + lane * 64 + i] = -run * 11.313708498984761f; }
            { float mq = 0.f, mk = 0.f;
              mq = fmaxf(fabsf(qg[lane]), fabsf(qg[lane + 64])); mk = fmaxf(fabsf(kg[lane]), fabsf(kg[lane + 64]));
              for (int o = 32; o >= 1; o >>= 1) { mq = fmaxf(mq, __shfl_xor(mq, o)); mk = fmaxf(mk, __shfl_xor(mk, o)); }
              if (lane == 0) fneg[(size_t)gw * 4160 + 4096] = (104.f + 2.f * 128.f * 0.08838834764831845f * mq * mk) * 11.313708498984761f; }
        }
    }
    if (IN(PH_FOXPREP)) for (int rep_ = 0; rep_ < REPS[18]; ++rep_) { if (rep_) xcd_barrier(bar); PH_IDS();
        __syncthreads(); GBUFS();
        const float* cw_ = ARG_IN(6); const float* al_ = ARG_IN(7); const float* dt_ = ARG_IN(8);
        for (int ci = bx; ci < 1024; ci += G) gd::gdn_chunk(ci, zb, zs, cw_, al_, dt_, gbufs, (LAS char*)lds);
    }
    SEAM(PH_FOXPREP);
    if (IN(PH_ATTN0)) for (int rep_ = 0; rep_ < REPS[PH_ATTN0]; ++rep_) { if (rep_) xcd_barrier(bar);
        { GBUFS(); for (int rs_ = 0; rs_ < REPS[19]; ++rs_) { if (rs_) xcd_barrier(bar); if (bx < 64) gd::gdn_scan(bx & 15, bx >> 4, gbufs, (LAS char*)lds); } }
        if (G == 256) { const int n_ = (bx - 64) >> 4, bh = bx & 15, b = bh >> 2, h = bh & 3; const bf16_t* base = zb + (size_t)b * 4096 * 3584 + h * 128;
            for (int k2_ = 0; k2_ < KN[2]; ++k2_)
            for (int u_ = 0; u_ < 2; ++u_) { const int cur = bx < 64 ? -1 : (u_ == 0 ? 15 - n_ : (n_ >= 8 ? 11 - n_ : -1)); if (cur < 0) continue;
                at::attn_unit<0, 3584, 1024>(base, base + 512, base + 1024, mixb + (size_t)b * 4096 * 1024 + h * 128, fneg + (size_t)bh * 4160, 2 * cur, 2 * cur + 1, (LAS char*)lds); } }
        else for (int L = bx; L < 256; L += G) { const int bh = L & 15, cur = L >> 4, b = bh >> 2, h = bh & 3;
            const bf16_t* base = zb + (size_t)b * 4096 * 3584 + h * 128;
            at::attn_unit<0, 3584, 1024>(base, base + 512, base + 1024, mixb + (size_t)b * 4096 * 1024 + h * 128, fneg + (size_t)bh * 4160, 2 * cur, 2 * cur + 1, (LAS char*)lds); }
        if (bx >= 64 && G == 256 && rep_ == 0) {
            PH_IDS();
            const float* w_e1 = ARG_IN(21); const float* w_e2 = ARG_IN(22);
            const int n_ = (bx - 64) >> 4, rounds_ = tail_rounds(n_), prev_ = tail_prev(n_);
            const int start_ = 16 * prev_ + (bx & 15) * rounds_;
            auto dec_ex = [&](int I) -> TwItem { return tw_expert(I, w_e1, w_e2, (unsigned char*)W1e, (unsigned char*)W2e, lane, wave); };
            TW_LOOP(true, start_, start_ + rounds_, 1, dec_ex, 64.f);
            __syncthreads();
        }
    }
    SEAM(PH_ATTN0);
    if (IN(PH_GDN3)) for (int rep_ = 0; rep_ < REPS[PH_GDN3]; ++rep_) { if (rep_) xcd_barrier(bar); GBUFS(); const float* on_ = ARG_IN(9); for (int ci = bx; ci < 1024; ci += G) gd::gdn_out(ci, gbufs, zb, on_, mixb, (LAS char*)lds); }
    SEAM(PH_GDN3);
    if (IN(PH_OUT0)) for (int rep_ = 0; rep_ < REPS[PH_OUT0]; ++rep_) { if (rep_) xcd_barrier(bar); DenseOrder S; S.init(T_, 1024, G, bx); EpiResB<false> E{hA, ARG_IN(0), 1024}; gemm_phase(lds, mixb, Wout0, 1024, S, E); }
    SEAM(PH_OUT0);
    if (IN(PH_NORM2)) for (int rep_ = 0; rep_ < REPS[PH_NORM2]; ++rep_) { if (rep_) xcd_barrier(bar); PH_IDS(); const float* g_in = ARG_IN(11); for (int m = gw; m < T_; m += 8 * NGW) { f32x4 v[8][4]; rms_rows<8, false, true>(hA, g_in, hn, m, NGW, lane, v); } }
    for (int k3_ = 1; k3_ < KN[3]; ++k3_) xcd_barrier(bar);
    SEAM(PH_NORM2);
    if (IN(PH_GU)) for (int rep_ = 0; rep_ < REPS[PH_GU]; ++rep_) { if (rep_) xcd_barrier(bar); DenseOrder S; S.init(T_, 5632, G, bx); EpiSwiglu8 E{(unsigned char*)zb, 2816, 4.f}; gemm_phase(lds, hn, Wgu, 1024, S, E);
        if (bx >= 128 && G == 256 && rep_ == 0 && GU_R > 0) { PH_IDS(); __syncthreads();
            const float* w_e1 = ARG_IN(21); const float* w_e2 = ARG_IN(22);
            auto dec_ex = [&](int I) -> TwItem { return tw_expert(I, w_e1, w_e2, (unsigned char*)W1e, (unsigned char*)W2e, lane, wave); };
            TW_LOOP(true, NT_TAIL / 8 + (bx - 128), NT_TAIL / 8 + 128 * GU_R, 128, dec_ex, 64.f);
            __syncthreads(); } }
    SEAM(PH_GU);
    if (IN(PH_DN)) for (int rep_ = 0; rep_ < REPS[PH_DN]; ++rep_) { if (rep_) xcd_barrier(bar); DenseOrder S; S.init(T_, 1024, G, bx); EpiResB<true> E{hB, hA, 1024}; gemm_phase<EpiResB<true>, DenseOrder, true>(lds, zb, Wdn, 1408, S, E, 121, 125); }
    SEAM(PH_DN);
    if (IN(PH_NORM3)) for (int rep_ = 0; rep_ < REPS[PH_NORM3]; ++rep_) { if (rep_) xcd_barrier(bar); PH_IDS(); const float* g_in = ARG_IN(14); for (int m = gw; m < T_; m += 8 * NGW) { f32x4 v[8][4]; rms_rows<8, true, true>(hB, g_in, hn, m, NGW, lane, v); } }
    SEAM(PH_NORM3);
    if (IN(PH_QKV)) for (int rep_ = 0; rep_ < REPS[PH_QKV]; ++rep_) { if (rep_) xcd_barrier(bar); QkvOrder S{G, bx}; EpiQkvMoba E{zb, ARG_IN(16), ARG_IN(17), ropec, ropes, kmean, lds + 131072}; gemm_phase<EpiQkvMoba, QkvOrder, true>(lds, hn, Wqkv, 512, S, E, 121, 127); }

    SEAM(PH_QKV);
    if (IN(PH_ATTN1)) for (int rep_ = 0; rep_ < REPS[PH_ATTN1]; ++rep_) { if (rep_) xcd_barrier(bar);
        for (int L = bx; L < 512; L += G) { const int bh = L >> 4, x = (L < 256) ? (L & 15) : 15 - (L & 15), b = bh >> 3, h = bh & 7;
            const bf16_t* base = zb + (size_t)b * 4096 * 3072 + h * 128;
            at::attn_unit<1, 3072, 1024>(base, base + 1024, base + 2048, mixb + (size_t)b * 4096 * 1024 + h * 128, kmean + (size_t)bh * 16 * 128, 2 * x, 2 * x + 1, (LAS char*)lds); }
    }
    SEAM(PH_ATTN1);
    if (IN(PH_OUT1)) for (int rep_ = 0; rep_ < REPS[PH_OUT1]; ++rep_) { if (rep_) xcd_barrier(bar); DenseOrder S; S.init(T_, 1024, G, bx); EpiResB<true> E{hA, hB, 1024}; gemm_phase(lds, mixb, Wout1, 1024, S, E); }
    SEAM(PH_OUT1);
    if (IN(PH_ROUTE)) { PH_IDS();
        LAS float* wr_l = (LAS float*)lds;
        LAS int* tk = (LAS int*)(lds + 32768);
        LAS int* pos = (LAS int*)(lds + 32768 + 256);
        LAS int* ebase = (LAS int*)(lds + 32768 + 1024);
        const float* w_r = ARG_IN(20); const float* g19 = ARG_IN(19);
        { f32x4 t_[4];
#pragma unroll
          for (int j = 0; j < 4; ++j) t_[j] = *(const f32x4*)(w_r + (size_t)(tid + 512 * (j >> 1)) * 8 + 4 * (j & 1));
#pragma unroll
          for (int j = 0; j < 4; ++j) { const int k = tid + 512 * (j >> 1), e0 = 4 * (j & 1); wr_l[(e0 + 0) * 1024 + k] = t_[j].x; wr_l[(e0 + 1) * 1024 + k] = t_[j].y; wr_l[(e0 + 2) * 1024 + k] = t_[j].z; wr_l[(e0 + 3) * 1024 + k] = t_[j].w; } }
        __syncthreads();
        for (int g0 = bx * 64; g0 < T_; g0 += G * 64) {
            { f32x4 v[8][4]; rms_rows<8, true, true>(hA, g19, hn, g0 + wave * 8, 1, lane, v);
              float b0[8], b1[8]; int i0[8], i1[8];
#pragma unroll
              for (int r = 0; r < 8; ++r) { b0[r] = -INFINITY; b1[r] = -INFINITY; i0[r] = -1; i1[r] = -1; }
#pragma unroll
              for (int e = 0; e < 8; ++e) { f32x2 a[8];
#pragma unroll
                  for (int r = 0; r < 8; ++r) a[r] = (f32x2){0.f, 0.f};
#pragma unroll
                  for (int q = 0; q < 4; ++q) { const f32x4 w4 = *(const LAS f32x4*)(wr_l + e * 1024 + 256 * q + 4 * lane);
#pragma unroll
                      for (int r = 0; r < 8; ++r) { a[r] += v[r][q].xy * w4.xy; a[r] += v[r][q].zw * w4.zw; } }
#pragma unroll
                  for (int r = 0; r < 8; ++r) { const float l = wave_sum(a[r].x + a[r].y);
                      if (i0[r] < 0 || l > b0[r]) { b1[r] = b0[r]; i1[r] = i0[r]; b0[r] = l; i0[r] = e; } else if (i1[r] < 0 || l > b1[r]) { b1[r] = l; i1[r] = e; } } }
#pragma unroll
              for (int rr = 0; rr < 8; ++rr) { const int tl = wave * 8 + rr, m = g0 + tl;
                if (lane == 0) { const float e1 = expf(b1[rr] - b0[rr]); gate[(size_t)m * 2] = 1.f / (1.f + e1); gate[(size_t)m * 2 + 1] = e1 / (1.f + e1); tk[tl] = i0[rr] | (i1[rr] << 8); } } }
            __syncthreads();
            if (wave == 0) { const int p = tk[lane], e0_ = p & 255, e1_ = p >> 8;
#pragma unroll
                for (int e = 0; e < 8; ++e) { const unsigned long long mk = __ballot(e0_ == e || e1_ == e); const int before = __popcll(mk & ((1ull << lane) - 1ull));
                    if (e0_ == e) pos[lane * 2] = before; if (e1_ == e) pos[lane * 2 + 1] = before;
                    if (lane == e) { const int c = __popcll(mk); ebase[e] = c ? atomicAdd(&cnt[64 * e], c) : 0; } } }
            __syncthreads();
            if (tid < 128) { const int t = tid >> 1, s = tid & 1; const int p = tk[t]; const int e = s ? (p >> 8) : (p & 255); idx[e * ECAP + ebase[e] + pos[t * 2 + s]] = (g0 + t) * 2 + s; }
            __syncthreads();
        }
    }
    SEAM(PH_ROUTE);
    if (IN(PH_MOE1)) for (int rep_ = 0; rep_ < REPS[PH_MOE1]; ++rep_) { if (rep_) xcd_barrier(bar); MoeOrder S{28, G, bx, cnt, idx}; EpiSwiglu8 E{(unsigned char*)zb, 3584, 4.f}; gemm_phase<EpiSwiglu8, MoeOrder, true>(lds, hn, W1e, 512, S, E, 121, 127); }
    SEAM(PH_MOE1);
    if (IN(PH_MOE2)) for (int rep_ = 0; rep_ < REPS[PH_MOE2]; ++rep_) { if (rep_) xcd_barrier(bar); MoeOrder S{4, G, bx, cnt, nullptr}; EpiMoeOut E{ybuf, idx}; gemm_phase<EpiMoeOut, MoeOrder, true>(lds, zb, W2e, 1792, S, E, 121, 125); }
    SEAM(PH_MOE2);
    if (IN(PH_COMB)) for (int rep_ = 0; rep_ < REPS[PH_COMB]; ++rep_) { if (rep_) xcd_barrier(bar); PH_IDS();
        float* o_out = ARG_OUT;
        for (int m = gw; m < T_; m += NGW) {
            const float g0 = gate[(size_t)m * 2], g1 = gate[(size_t)m * 2 + 1];
            const u32x2* hr = (const u32x2*)(hA + (size_t)m * D_) + lane; f32x4* orow = (f32x4*)(o_out + (size_t)m * D_) + lane;
            const u32x2* y0 = (const u32x2*)(ybuf + (size_t)m * D_) + lane; const u32x2* y1 = (const u32x2*)(ybuf + (size_t)(T_ + m) * D_) + lane;
#pragma unroll
            for (int j = 0; j < 4; ++j) { const u32x2 hb_ = hr[64 * j]; f32x4 h; h.x = __uint_as_float(hb_.x << 16); h.y = __uint_as_float(hb_.x & 0xffff0000u); h.z = __uint_as_float(hb_.y << 16); h.w = __uint_as_float(hb_.y & 0xffff0000u); const u32x2 a = y0[64 * j], b = y1[64 * j];
                f32x4 o; o.x = h.x + g0 * __uint_as_float(a.x << 16) + g1 * __uint_as_float(b.x << 16); o.y = h.y + g0 * __uint_as_float(a.x & 0xffff0000u) + g1 * __uint_as_float(b.x & 0xffff0000u);
                o.z = h.z + g0 * __uint_as_float(a.y << 16) + g1 * __uint_as_float(b.y << 16); o.w = h.w + g0 * __uint_as_float(a.y & 0xffff0000u) + g1 * __uint_as_float(b.y & 0xffff0000u);
                orow[64 * j] = o; }
        }
    }
#undef IN
#undef ws
#undef ctl
#undef cnt
#undef idx
#undef gate
#undef zs
#undef hn
#undef mixb
#undef hA
#undef hB
#undef zb
#undef ybuf
#undef fneg
#undef kmean
#undef ropec
#undef ropes
}
}


extern "C" void kernel_launch(void* const* d_in, const int* in_sizes, int n_in, void* d_out, int out_size, void* d_ws, size_t ws_size, hipStream_t st) {
    static bool attr_done = false;
    if (!attr_done) { attr_done = true; (void)hipFuncSetAttribute((const void*)mk::mk_fwd, hipFuncAttributeMaxDynamicSharedMemorySize, mk::LDS_BYTES); }
    mk::Args a; memset(&a, 0, sizeof(a));
    for (int i = 0; i < 23; ++i) a.in[i] = (const float*)d_in[i];
    a.out = (float*)d_out; a.ws = (unsigned char*)d_ws;
    (void)hipMemsetAsync((char*)d_ws + mk::WS_CTL, 0, mk::CTL_ZERO_BYTES, st);
    a.ph_lo = 0; a.ph_hi = mk::PH_END;
    hipLaunchKernelGGL(mk::mk_fwd, dim3(256), dim3(512), mk::LDS_BYTES, st, a);
}
```
